# Optimizing an MI355X kernel written in HIP

```python
import jax, jax.numpy as jnp
from jax import lax
import numpy as np

D_MODEL = 1024
BATCH = 8
SEQ = 2048
DEPTH = 2
DEC_BATCH = 128
DEC_SEQ = 8
PAST_LEN = 16384
PAGE_SIZE = 128

D_MIX = D_MODEL
RG_WIDTH = D_MIX // 2
RG_BLOCKS = 8
RG_BLOCK = RG_WIDTH // RG_BLOCKS
RG_C = 8.0
DN_HEADS = 4
DN_HEAD_DIM = (D_MIX - RG_WIDTH) // DN_HEADS
DN_WIDTH = DN_HEADS * DN_HEAD_DIM
CONV_WIDTH = 4
CONV_CH = RG_WIDTH + 3 * DN_WIDTH
CHUNK = 64
D_FF = 2816
EPS = 1e-6
IN_COLS = 2 * RG_WIDTH + 4 * DN_WIDTH + 2 * DN_HEADS

kernel_name = 'hymba_rglru_gdn_macaron_step'


def rmsnorm(x, g):
    xf = x.astype(jnp.float32)
    y = xf * lax.rsqrt(jnp.mean(xf * xf, axis=-1, keepdims=True) + EPS)
    return (y * g.astype(jnp.float32)).astype(x.dtype)


def l2norm(x):
    return x * lax.rsqrt(jnp.sum(x * x, axis=-1, keepdims=True) + EPS)


def swiglu(h, w_up, w_down):
    u = h @ w_up
    gate, up = u[..., :D_FF], u[..., D_FF:]
    return (jax.nn.silu(gate) * up) @ w_down


def causal_conv(x, buf, w):
    L = x.shape[1]
    xp = jnp.concatenate([buf.astype(x.dtype), x], axis=1)
    out = sum(xp[:, j:j + L] * w[j] for j in range(CONV_WIDTH))
    return out, xp[:, -(CONV_WIDTH - 1):]


def _lin_combine(c1, c2):
    a1, b1 = c1
    a2, b2 = c2
    return a1 * a2, a2 * b1 + b2


def rg_lru(xr, h0, w_a, b_a, w_x, b_x, lam):
    B, L, _ = xr.shape
    xb = xr.reshape(B, L, RG_BLOCKS, RG_BLOCK)
    r = jax.nn.sigmoid(jnp.einsum('blhi,hij->blhj', xb, w_a).reshape(B, L, RG_WIDTH) + b_a)
    i = jax.nn.sigmoid(jnp.einsum('blhi,hij->blhj', xb, w_x).reshape(B, L, RG_WIDTH) + b_x)
    log_a = -RG_C * r * jax.nn.softplus(-lam.astype(jnp.float32))
    a = jnp.exp(log_a)
    b = jnp.sqrt(-jnp.expm1(2.0 * log_a)) * (i * xr)
    b = b.at[:, 0].add(a[:, 0] * h0)
    _, h = lax.associative_scan(_lin_combine, (a, b), axis=1)
    return h, h[:, -1]


def gated_delta(q, k, v, g, beta, S0):
    B, L, H, Dk = q.shape
    Dv = v.shape[-1]
    C = min(CHUNK, L)
    n = -(-L // C)
    pad = n * C - L

    def blocks(t):
        t = jnp.pad(t, [(0, 0), (0, pad)] + [(0, 0)] * (t.ndim - 2))
        t = t.reshape((B, n, C) + t.shape[2:])
        return jnp.moveaxis(t, 3, 2).swapaxes(0, 1)

    qb, kb, vb, gb, bb = blocks(q), blocks(k), blocks(v), blocks(g), blocks(beta)
    G = jnp.cumsum(gb, axis=-1)
    idx = jnp.arange(C)
    incl = idx[:, None] >= idx[None, :]
    strict = idx[:, None] > idx[None, :]
    decay = jnp.exp(jnp.where(incl, G[..., :, None] - G[..., None, :], -jnp.inf))
    kbeta = kb * bb[..., None]
    A = jnp.where(strict, jnp.einsum('nbhid,nbhjd->nbhij', kbeta, kb) * decay, 0.0)
    IA = A + jnp.eye(C, dtype=A.dtype)
    rhs = jnp.concatenate([vb * bb[..., None], kbeta * jnp.exp(G)[..., None]], axis=-1)
    sol = lax.linalg.triangular_solve(IA, rhs, left_side=True, lower=True, unit_diagonal=True)
    u, w = sol[..., :Dv], sol[..., Dv:]
    att = jnp.einsum('nbhid,nbhjd->nbhij', qb, kb) * decay

    def step(S, inp):
        qc, kc, uc, wc, ac, Gc = inp
        v_new = uc - jnp.einsum('bhcd,bhde->bhce', wc, S)
        o = jnp.einsum('bhcd,bhde->bhce', qc * jnp.exp(Gc)[..., None], S) + jnp.einsum('bhij,bhje->bhie', ac, v_new)
        gl = Gc[..., -1]
        S = S * jnp.exp(gl)[..., None, None] + jnp.einsum('bhcd,bhce->bhde', kc * jnp.exp(gl[..., None] - Gc)[..., None], v_new)
        return S, o

    S, o = lax.scan(step, S0, (qb, kb, u, w, att, G))
    o = jnp.moveaxis(o.swapaxes(0, 1), 2, 3).reshape(B, n * C, H, Dv)[:, :L]
    return o, S


def mixer(h, conv_buf, rg_h0, S0, w_in, conv_w, conv_b_rg, rg_w_a, rg_b_a, rg_w_x, rg_b_x,
          rg_lambda, dn_a_log, dn_dt_bias, dn_norm_w, w_out):
    B, L, _ = h.shape
    f32 = jnp.float32
    proj = h @ w_in
    conv_out, new_buf = causal_conv(proj[..., :CONV_CH], conv_buf, conv_w)
    conv_out = conv_out.astype(f32)
    gates = proj[..., CONV_CH:CONV_CH + RG_WIDTH + DN_WIDTH].astype(f32)
    scal = proj[..., CONV_CH + RG_WIDTH + DN_WIDTH:].astype(f32)
    xr = conv_out[..., :RG_WIDTH] + conv_b_rg.astype(f32)
    rg_h, rg_last = rg_lru(xr, rg_h0.astype(f32), rg_w_a, rg_b_a, rg_w_x, rg_b_x, rg_lambda)
    rg_out = rg_h * jax.nn.gelu(gates[..., :RG_WIDTH])
    qkv = jax.nn.silu(conv_out[..., RG_WIDTH:]).reshape(B, L, 3, DN_HEADS, DN_HEAD_DIM)
    q = l2norm(qkv[:, :, 0]) * (DN_HEAD_DIM ** -0.5)
    k = l2norm(qkv[:, :, 1])
    v = qkv[:, :, 2]
    beta = jax.nn.sigmoid(scal[..., :DN_HEADS])
    g = -jnp.exp(dn_a_log.astype(f32)) * jax.nn.softplus(scal[..., DN_HEADS:] + dn_dt_bias.astype(f32))
    o, S = gated_delta(q, k, v, g, beta, S0.astype(f32))
    o = rmsnorm(o, dn_norm_w) * jax.nn.silu(gates[..., RG_WIDTH:].reshape(B, L, DN_HEADS, DN_HEAD_DIM))
    mixed = jnp.concatenate([rg_out, o.reshape(B, L, DN_WIDTH)], axis=-1).astype(h.dtype)
    return mixed @ w_out, new_buf, rg_last, S


def setup_inputs(seed: int = 0) -> dict:
    key = jax.random.key(seed)
    ks = iter(jax.random.split(key, 40))

    def nrm(shape, scale):
        return jax.random.normal(next(ks), shape, jnp.float32) * scale

    def gain(shape):
        return 1.0 + nrm(shape, 0.05)

    a0 = jax.random.uniform(next(ks), (DEPTH, RG_WIDTH), jnp.float32, 0.9, 0.999)
    p = a0 ** (1.0 / RG_C)
    rg_lambda = jnp.log(p) - jnp.log1p(-p)
    dn_a_log = jnp.log(jax.random.uniform(next(ks), (DEPTH, DN_HEADS), jnp.float32, 1.0, 16.0))
    dt = jnp.exp(jax.random.uniform(next(ks), (DEPTH, DN_HEADS), jnp.float32, np.log(1e-3), np.log(1e-1)))
    dn_dt_bias = jnp.log(jnp.expm1(dt))
    return {
        'x_prompt': nrm((BATCH, SEQ, D_MODEL), 1.0),
        'x_sample': nrm((DEC_BATCH, DEC_SEQ, D_MODEL), 1.0),
        'state_conv': nrm((DEPTH, DEC_BATCH, CONV_WIDTH - 1, CONV_CH), 1.0),
        'state_rglru': nrm((DEPTH, DEC_BATCH, RG_WIDTH), 0.5),
        'state_delta': nrm((DEPTH, DEC_BATCH, DN_HEADS, DN_HEAD_DIM, DN_HEAD_DIM), 0.1),
        'ffn1_norm_pre': gain((DEPTH, D_MODEL)),
        'ffn1_w_up': nrm((DEPTH, D_MODEL, 2 * D_FF), D_MODEL ** -0.5),
        'ffn1_w_down': nrm((DEPTH, D_FF, D_MODEL), D_FF ** -0.5),
        'ffn1_norm_post': gain((DEPTH, D_MODEL)),
        'mix_norm_pre': gain((DEPTH, D_MODEL)),
        'w_in': nrm((DEPTH, D_MODEL, IN_COLS), D_MODEL ** -0.5),
        'conv_w': nrm((DEPTH, CONV_WIDTH, CONV_CH), CONV_WIDTH ** -0.5),
        'conv_b_rg': nrm((DEPTH, RG_WIDTH), 0.02),
        'rg_w_a': nrm((DEPTH, RG_BLOCKS, RG_BLOCK, RG_BLOCK), RG_BLOCK ** -0.5),
        'rg_b_a': nrm((DEPTH, RG_WIDTH), 0.02),
        'rg_w_x': nrm((DEPTH, RG_BLOCKS, RG_BLOCK, RG_BLOCK), RG_BLOCK ** -0.5),
        'rg_b_x': nrm((DEPTH, RG_WIDTH), 0.02),
        'rg_lambda': rg_lambda,
        'dn_a_log': dn_a_log,
        'dn_dt_bias': dn_dt_bias,
        'dn_norm_w': gain((DEPTH, DN_HEAD_DIM)),
        'w_out': nrm((DEPTH, D_MIX, D_MODEL), D_MIX ** -0.5),
        'mix_norm_post': gain((DEPTH, D_MODEL)),
        'ffn2_norm_pre': gain((DEPTH, D_MODEL)),
        'ffn2_w_up': nrm((DEPTH, D_MODEL, 2 * D_FF), D_MODEL ** -0.5),
        'ffn2_w_down': nrm((DEPTH, D_FF, D_MODEL), D_FF ** -0.5),
        'ffn2_norm_post': gain((DEPTH, D_MODEL)),
        'final_norm': gain((D_MODEL,)),
    }


def reference(x_prompt, x_sample, state_conv, state_rglru, state_delta,
              ffn1_norm_pre, ffn1_w_up, ffn1_w_down, ffn1_norm_post,
              mix_norm_pre, w_in, conv_w, conv_b_rg, rg_w_a, rg_b_a, rg_w_x, rg_b_x,
              rg_lambda, dn_a_log, dn_dt_bias, dn_norm_w, w_out, mix_norm_post,
              ffn2_norm_pre, ffn2_w_up, ffn2_w_down, ffn2_norm_post, final_norm):

    def run(x, conv_st, rg_st, dn_st):
        new_conv, new_rg, new_dn = [], [], []
        for l in range(DEPTH):
            h = swiglu(rmsnorm(x, ffn1_norm_pre[l]), ffn1_w_up[l], ffn1_w_down[l])
            x = x + 0.5 * rmsnorm(h, ffn1_norm_post[l])
            h, cb, rh, S = mixer(rmsnorm(x, mix_norm_pre[l]), conv_st[l], rg_st[l], dn_st[l],
                                 w_in[l], conv_w[l], conv_b_rg[l], rg_w_a[l], rg_b_a[l],
                                 rg_w_x[l], rg_b_x[l], rg_lambda[l], dn_a_log[l],
                                 dn_dt_bias[l], dn_norm_w[l], w_out[l])
            x = x + rmsnorm(h, mix_norm_post[l])
            h = swiglu(rmsnorm(x, ffn2_norm_pre[l]), ffn2_w_up[l], ffn2_w_down[l])
            x = x + 0.5 * rmsnorm(h, ffn2_norm_post[l])
            new_conv.append(cb.astype(conv_st.dtype))
            new_rg.append(rh.astype(rg_st.dtype))
            new_dn.append(S.astype(dn_st.dtype))
        y = rmsnorm(x, final_norm)
        return y, jnp.stack(new_conv), jnp.stack(new_rg), jnp.stack(new_dn)

    dt = x_prompt.dtype
    zero_conv = jnp.zeros((DEPTH, BATCH, CONV_WIDTH - 1, CONV_CH), dt)
    zero_rg = jnp.zeros((DEPTH, BATCH, RG_WIDTH), dt)
    zero_dn = jnp.zeros((DEPTH, BATCH, DN_HEADS, DN_HEAD_DIM, DN_HEAD_DIM), dt)
    y_prompt, conv_p, rg_p, dn_p = run(x_prompt, zero_conv, zero_rg, zero_dn)
    y_sample, conv_s, rg_s, dn_s = run(x_sample, state_conv, state_rglru, state_delta)
    return (y_prompt, y_sample, conv_p, rg_p, dn_p, conv_s, rg_s, dn_s)
```

```cpp
#include <hip/hip_runtime.h>
#include <cstdio>
#include <cstdint>
namespace pg8 {
#define PG8_LAS __attribute__((address_space(3)))
typedef unsigned short bf16_t;
typedef short bf16x8 __attribute__((ext_vector_type(8)));
typedef float f32x4 __attribute__((ext_vector_type(4)));
typedef unsigned u32x4 __attribute__((ext_vector_type(4)));
constexpr int BM = 256, BK = 64, HALF = 128, HTB = HALF * BK * 2  , STAGE_BYTES = 8 * HTB, NXCD = 8, WGM = 8;

__host__ __device__ __forceinline__ int lds_byte(int r, int c) { const int st = (r >> 4) * 2 + (c >> 5), rr = r & 15, cc = c & 31, ob = rr * 64 + cc * 2; return st * 1024 + (ob ^ (((ob >> 9) & 1) << 5)); }
__host__ __device__ __forceinline__ void stage_rc(int b, int& R, int& C) { const int st = b / 1024, sb = b % 1024, swz = sb ^ (((sb >> 9) & 1) << 5); R = (st >> 1) * 16 + swz / 64; C = (st & 1) * 32 + (swz % 64) / 2; }
__host__ __device__ __forceinline__ int perm32(int rho) { const int n = rho >> 4, i = rho & 15; return 8 * (i >> 2) + 4 * n + (i & 3); }

struct Unit { int pm, pn, kt0, nt, ks; };
struct Gemm { const bf16_t* A; const bf16_t* Bt; int M, N, K; };

struct StaticOrder {
    int nM, nN, nwg, G, c, ntf;
    __host__ __device__ void init(int M, int N, int G_, int c_) { nM = M / BM; nN = N / BM; nwg = nM * nN; G = G_; c = c_; }
    __host__ __device__ __forceinline__ bool next(int i, Unit& u) const {
        const long L = (long)i * G + c; if (L >= nwg) return false;
        int wgid = (int)L; { const int q = nwg / NXCD, r = nwg % NXCD, xcd = wgid % NXCD, off = wgid / NXCD; wgid = (xcd < r ? xcd * (q + 1) : r * (q + 1) + (xcd - r) * q) + off; }
        const int nig = WGM * nN, gid = wgid / nig, fm = gid * WGM, gsz = (nM - fm) < WGM ? (nM - fm) : WGM;
        u.pm = fm + ((wgid % nig) % gsz); u.pn = (wgid % nig) / gsz; u.kt0 = 0; u.nt = ntf; u.ks = 0; return true;
    }
    __device__ __forceinline__ void a_ready(const Unit&) const {}
    __device__ __forceinline__ void done(const Unit&) const {}
};
struct SplitOrder {
    StaticOrder full; int mfull, mrest, nN, nsplit, nts, nfull;
    __host__ __device__ void init(int Mfull, int Mrest, int N, int K, int nsplit_, int G_, int c_) { full.init(Mfull, N, G_, c_); full.ntf = K / BK; mfull = Mfull / BM; mrest = Mrest / BM; nN = N / BM; nsplit = nsplit_; nts = K / BK / nsplit_; nfull = full.nwg; }
    __host__ __device__ __forceinline__ bool next(int i, Unit& u) const {
        const int L = i * full.G + full.c;
        const int j = L - nfull, nrest = mrest * nN * nsplit;
        if (j >= nrest) return false;
        Unit f; f.pm = 0; f.pn = 0; f.kt0 = 0; f.nt = 0; f.ks = 0;
        if (j < 0) (void)full.next(i, f);
        const int jj = j < 0 ? 0 : j, ks = jj % nsplit, q = jj / nsplit;
        const bool isfull = j < 0;
        u.pm = isfull ? f.pm : mfull + q / nN; u.pn = isfull ? f.pn : q % nN; u.ks = isfull ? 0 : ks; u.kt0 = isfull ? 0 : ks * nts; u.nt = isfull ? full.ntf : nts;
        return true;
    }
    __device__ __forceinline__ void a_ready(const Unit&) const {}
    __device__ __forceinline__ void done(const Unit&) const {}
};


__device__ __forceinline__ unsigned cvt_pk_bf16(float lo, float hi) { unsigned r; asm volatile("v_cvt_pk_bf16_f32 %0, %1, %2" : "=v"(r) : "v"(lo), "v"(hi)); return r; }
typedef float f32x2 __attribute__((ext_vector_type(2)));
struct EpiF32 {
    static constexpr bool PERM = false, AFTER_DRAIN = false;
    float* C; int ldc;
    __device__ __forceinline__ void operator()(const f32x4 (&acc)[2][2][4][2], const Unit& u, int wr, int wc, int fr, int fq) const {
        const int row0 = u.pm * BM + wr * 64 + fr, col0 = u.pn * BM + wc * 32 + 4 * fq;
#pragma unroll
        for (int ai = 0; ai < 2; ++ai)
#pragma unroll
            for (int m = 0; m < 4; ++m) { float* rowp = C + (size_t)(row0 + ai * HALF + m * 16) * ldc + col0;
#pragma unroll
                for (int bj = 0; bj < 2; ++bj)
#pragma unroll
                    for (int n = 0; n < 2; ++n) *(f32x4*)(rowp + bj * HALF + n * 16) = acc[ai][bj][m][n]; }
    }
};
struct EpiBf16 {
    static constexpr bool PERM = true, AFTER_DRAIN = false;
    bf16_t* O; int ldc;
    __device__ __forceinline__ void operator()(const f32x4 (&acc)[2][2][4][2], const Unit& u, int wr, int wc, int fr, int fq) const {
        const int row0 = u.pm * BM + wr * 64 + fr, col0 = u.pn * BM + wc * 32 + 8 * fq;
#pragma unroll
        for (int ai = 0; ai < 2; ++ai)
#pragma unroll
            for (int m = 0; m < 4; ++m) { bf16_t* rowp = O + (size_t)(row0 + ai * HALF + m * 16) * ldc + col0;
#pragma unroll
                for (int bj = 0; bj < 2; ++bj) { const f32x4 v0 = acc[ai][bj][m][0], v1 = acc[ai][bj][m][1];
                    u32x4 w; w.x = cvt_pk_bf16(v0[0], v0[1]); w.y = cvt_pk_bf16(v0[2], v0[3]); w.z = cvt_pk_bf16(v1[0], v1[1]); w.w = cvt_pk_bf16(v1[2], v1[3]);
                    *(u32x4*)(rowp + bj * HALF) = w; } }
    }
};
__device__ __forceinline__ float silu_f(float x) { return x * __builtin_amdgcn_rcpf(1.0f + __builtin_amdgcn_exp2f(-1.44269504089f * x)); }
struct EpiSwiGLU {
    static constexpr bool PERM = true, AFTER_DRAIN = false;
    bf16_t* O; int ldc;
    __device__ __forceinline__ void operator()(const f32x4 (&acc)[2][2][4][2], const Unit& u, int wr, int wc, int fr, int fq) const {
        const int row0 = u.pm * BM + wr * 64 + fr, col0 = u.pn * HALF + wc * 32 + 8 * fq;
#pragma unroll
        for (int ai = 0; ai < 2; ++ai)
#pragma unroll
            for (int m = 0; m < 4; ++m) { bf16_t* rowp = O + (size_t)(row0 + ai * HALF + m * 16) * ldc + col0;
                const f32x4 g0 = acc[ai][0][m][0], g1 = acc[ai][0][m][1], u0 = acc[ai][1][m][0], u1 = acc[ai][1][m][1];
                u32x4 w;
                w.x = cvt_pk_bf16(silu_f(g0[0]) * u0[0], silu_f(g0[1]) * u0[1]); w.y = cvt_pk_bf16(silu_f(g0[2]) * u0[2], silu_f(g0[3]) * u0[3]);
                w.z = cvt_pk_bf16(silu_f(g1[0]) * u1[0], silu_f(g1[1]) * u1[1]); w.w = cvt_pk_bf16(silu_f(g1[2]) * u1[2], silu_f(g1[3]) * u1[3]);
                *(u32x4*)rowp = w; }
    }
};

constexpr int M_ROWS = 17408;
struct EpiAny {
    static constexpr bool PERM = true, AFTER_DRAIN = false;
    int mode; bf16_t* O; int ldo; int mfull; bf16_t* Oslab;
    __device__ __forceinline__ void operator()(const f32x4 (&acc)[2][2][4][2], const Unit& u, int wr, int wc, int fr, int fq) const {
        const int row0 = u.pm * BM + wr * 64 + fr;
        if (mode == 0) {
            const int col0 = u.pn * HALF + wc * 32 + 8 * fq;
#pragma unroll
            for (int ai = 0; ai < 2; ++ai)
#pragma unroll
                for (int m = 0; m < 4; ++m) { bf16_t* rowp = O + (size_t)(row0 + ai * HALF + m * 16) * ldo + col0;
                    const f32x4 g0 = acc[ai][0][m][0], g1 = acc[ai][0][m][1], u0 = acc[ai][1][m][0], u1 = acc[ai][1][m][1];
                    u32x4 w;
                    w.x = cvt_pk_bf16(silu_f(g0[0]) * u0[0], silu_f(g0[1]) * u0[1]); w.y = cvt_pk_bf16(silu_f(g0[2]) * u0[2], silu_f(g0[3]) * u0[3]);
                    w.z = cvt_pk_bf16(silu_f(g1[0]) * u1[0], silu_f(g1[1]) * u1[1]); w.w = cvt_pk_bf16(silu_f(g1[2]) * u1[2], silu_f(g1[3]) * u1[3]);
                    *(u32x4*)rowp = w; }
        } else {
            const int col0 = u.pn * BM + wc * 32 + 8 * fq;
            bf16_t* Ob = u.pm < mfull ? O : Oslab + (size_t)u.ks * ((size_t)(M_ROWS - mfull * BM) * ldo) - (size_t)(mfull * BM) * ldo;
#pragma unroll
            for (int ai = 0; ai < 2; ++ai)
#pragma unroll
                for (int m = 0; m < 4; ++m) { bf16_t* rowp = Ob + (size_t)(row0 + ai * HALF + m * 16) * ldo + col0;
#pragma unroll
                    for (int bj = 0; bj < 2; ++bj) { const f32x4 v0 = acc[ai][bj][m][0], v1 = acc[ai][bj][m][1];
                        u32x4 w; w.x = cvt_pk_bf16(v0[0], v0[1]); w.y = cvt_pk_bf16(v0[2], v0[3]); w.z = cvt_pk_bf16(v1[0], v1[1]); w.w = cvt_pk_bf16(v1[2], v1[3]);
                        *(u32x4*)(rowp + bj * HALF) = w; } }
        }
    }
};
template <class Epi, class Sched, bool ALIGN_EPI = false, bool SP2 = false>
__device__ __forceinline__ void gemm_phase(PG8_LAS unsigned char* lds, const Gemm g, const Sched& S, const Epi& E) {
    int tid_l = threadIdx.x; asm volatile("" : "+v"(tid_l));
    const int tid = tid_l, wid = __builtin_amdgcn_readfirstlane(tid >> 6), lane = tid & 63, wr = wid >> 2, wc = wid & 3, fr = lane & 15, fq = lane >> 4;
    const int K = g.K;
    unsigned voffA[2], voffB[2];
#pragma unroll
    for (int i = 0; i < 2; ++i) { int R, C; stage_rc(tid * 16 + i * 8192, R, C); const int Rb = Epi::PERM ? ((R & ~31) + perm32(R & 31)) : R;
        voffA[i] = (unsigned)(R * K + C) * 2u; voffB[i] = (unsigned)(Rb * K + C) * 2u; }
    const size_t kstep = (size_t)(BK * 2);
    const size_t hstep = (size_t)HALF * K * 2;
    const size_t tstep = 2 * hstep;
    const unsigned ldsw = (unsigned)wid * 1024u;
    const int aoff = lds_byte(wr * 64 + fr, fq * 8), boff = lds_byte(wc * 32 + fr, fq * 8);
#define PG8_SA(b, h) (((b) * 2 + (h)) * HTB)
#define PG8_SB(b, h) ((4 + (b) * 2 + (h)) * HTB)
#define PG8_STAGE(bufoff, gbase, voff) do { _Pragma("unroll") for (int _i = 0; _i < 2; ++_i) \
        __builtin_amdgcn_global_load_lds((const unsigned*)((const char*)(gbase) + (voff)[_i]), (PG8_LAS unsigned*)(lds + (bufoff) + ldsw + _i * 8192), 16, 0, 0); } while (0)
#define PG8_LDA(dst, b, h) do { _Pragma("unroll") for (int m = 0; m < 4; ++m) _Pragma("unroll") for (int k = 0; k < 2; ++k) dst[m][k] = *(const PG8_LAS bf16x8*)(lds + PG8_SA(b, h) + aoff + m * 2048 + k * 1024); } while (0)
#define PG8_LDB(dst, b, h) do { _Pragma("unroll") for (int n = 0; n < 2; ++n) _Pragma("unroll") for (int k = 0; k < 2; ++k) dst[n][k] = *(const PG8_LAS bf16x8*)(lds + PG8_SB(b, h) + boff + n * 2048 + k * 1024); } while (0)
#define PG8_MMA(ai, bj, At, Bt) do { __builtin_amdgcn_s_setprio(1); _Pragma("unroll") for (int m = 0; m < 4; ++m) _Pragma("unroll") for (int n = 0; n < 2; ++n) _Pragma("unroll") for (int k = 0; k < 2; ++k) \
        acc[ai][bj][m][n] = __builtin_amdgcn_mfma_f32_16x16x32_bf16(Bt[n][k], At[m][k], acc[ai][bj][m][n], 0, 0, 0); __builtin_amdgcn_s_setprio(0); } while (0)
#define PG8_WAIT_V(n) asm volatile("s_waitcnt vmcnt(" #n ")" ::: "memory")
#define PG8_WAIT_L(n) asm volatile("s_waitcnt lgkmcnt(" #n ")" ::: "memory")
#define PG8_BAR __builtin_amdgcn_s_barrier()
#define PG8_SCHED __builtin_amdgcn_sched_barrier(0)
    Unit cur, nxt; int ui = 0;
    if (!S.next(0, cur)) return;
    f32x4 acc[2][2][4][2];
#pragma unroll
    for (int a = 0; a < 2; ++a)
#pragma unroll
        for (int b = 0; b < 2; ++b)
#pragma unroll
            for (int m = 0; m < 4; ++m)
#pragma unroll
                for (int n = 0; n < 2; ++n) acc[a][b][m][n] = (f32x4){0.f, 0.f, 0.f, 0.f};
    bf16x8 At[4][2], B0[2][2], B1[2][2];
    const char* cA = (const char*)g.A + (size_t)cur.pm * tstep + (size_t)cur.kt0 * (BK * 2); const char* cB = (const char*)g.Bt + (size_t)cur.pn * tstep + (size_t)cur.kt0 * (BK * 2);
    S.a_ready(cur);
    if constexpr (SP2) {
        PG8_STAGE(PG8_SB(0, 0), cB, voffB); PG8_STAGE(PG8_SB(0, 1), cB + hstep, voffB); PG8_STAGE(PG8_SA(0, 0), cA, voffA); PG8_STAGE(PG8_SA(0, 1), cA + hstep, voffA);
        if (wr == 1) PG8_BAR;
        PG8_WAIT_V(2); PG8_BAR;
        PG8_STAGE(PG8_SB(1, 0), cB + kstep, voffB); PG8_STAGE(PG8_SA(1, 0), cA + kstep, voffA); PG8_STAGE(PG8_SB(1, 1), cB + hstep + kstep, voffB);
        PG8_WAIT_V(6); PG8_BAR;
    } else {
        PG8_STAGE(PG8_SB(0, 0), cB, voffB); PG8_STAGE(PG8_SA(0, 0), cA, voffA); PG8_STAGE(PG8_SB(0, 1), cB + hstep, voffB); PG8_STAGE(PG8_SA(0, 1), cA + hstep, voffA);
        if (wr == 1) PG8_BAR;
        PG8_WAIT_V(4); PG8_BAR;
        PG8_STAGE(PG8_SB(1, 0), cB + kstep, voffB); PG8_STAGE(PG8_SA(1, 0), cA + kstep, voffA); PG8_STAGE(PG8_SB(1, 1), cB + hstep + kstep, voffB);
        PG8_WAIT_V(6); PG8_BAR;
    }
    for (;;) {
        const bool has_next = S.next(ui + 1, nxt);
        const char* nA = has_next ? (const char*)g.A + (size_t)nxt.pm * tstep + (size_t)nxt.kt0 * (BK * 2) : cA; const char* nB = has_next ? (const char*)g.Bt + (size_t)nxt.pn * tstep + (size_t)nxt.kt0 * (BK * 2) : cB;
        const int nt = cur.nt;
        for (int t = 0; t < nt; t += 2) {
            const bool last = (t == nt - 2);
            const char* a1 = cA + (size_t)(t + 1) * kstep;
            const char* a2 = last ? nA : cA + (size_t)(t + 2) * kstep; const char* b2 = last ? nB : cB + (size_t)(t + 2) * kstep;
            const char* a3 = a2 + kstep; const char* b3 = b2 + kstep;
            if (last && has_next) S.a_ready(nxt);
            if constexpr (SP2) {
            PG8_LDB(B0, 0, 0); PG8_LDB(B1, 0, 1); PG8_SCHED; PG8_LDA(At, 0, 0); PG8_STAGE(PG8_SA(1, 1), a1 + hstep, voffA);
            PG8_WAIT_V(8); PG8_WAIT_L(0); PG8_BAR; PG8_MMA(0, 0, At, B0); PG8_MMA(0, 1, At, B1); PG8_BAR; PG8_SCHED;
            PG8_LDA(At, 0, 1); PG8_STAGE(PG8_SB(0, 0), b2, voffB); PG8_STAGE(PG8_SB(0, 1), b2 + hstep, voffB); PG8_STAGE(PG8_SA(0, 0), a2, voffA);
            PG8_WAIT_V(8); PG8_WAIT_L(0); PG8_BAR; PG8_MMA(1, 0, At, B0); PG8_MMA(1, 1, At, B1); PG8_BAR; PG8_SCHED;
            PG8_LDB(B0, 1, 0); PG8_LDB(B1, 1, 1); PG8_SCHED; PG8_LDA(At, 1, 0); PG8_STAGE(PG8_SA(0, 1), a2 + hstep, voffA);
            PG8_WAIT_V(8); PG8_WAIT_L(0); PG8_BAR; PG8_MMA(0, 0, At, B0); PG8_MMA(0, 1, At, B1); PG8_BAR; PG8_SCHED;
            PG8_LDA(At, 1, 1); PG8_STAGE(PG8_SB(1, 0), b3, voffB); PG8_STAGE(PG8_SB(1, 1), b3 + hstep, voffB); PG8_STAGE(PG8_SA(1, 0), a3, voffA);
            PG8_WAIT_V(8); PG8_WAIT_L(0); PG8_BAR; PG8_MMA(1, 0, At, B0); PG8_MMA(1, 1, At, B1); PG8_BAR; PG8_SCHED;
            } else {
            PG8_LDB(B0, 0, 0); PG8_SCHED; PG8_LDA(At, 0, 0); PG8_STAGE(PG8_SA(1, 1), a1 + hstep, voffA);
            PG8_WAIT_L(8); PG8_BAR; PG8_WAIT_L(0); PG8_MMA(0, 0, At, B0); PG8_BAR; PG8_SCHED;
            PG8_LDB(B1, 0, 1); PG8_STAGE(PG8_SB(0, 0), b2, voffB);
            PG8_BAR; PG8_WAIT_L(0); PG8_MMA(0, 1, At, B1); PG8_BAR;
            PG8_LDA(At, 0, 1); PG8_STAGE(PG8_SA(0, 0), a2, voffA);
            PG8_BAR; PG8_WAIT_L(0); PG8_MMA(1, 0, At, B0); PG8_BAR; PG8_SCHED;
            PG8_STAGE(PG8_SB(0, 1), b2 + hstep, voffB);
            PG8_WAIT_V(6); PG8_BAR; PG8_MMA(1, 1, At, B1); PG8_BAR;
            PG8_LDB(B0, 1, 0); PG8_SCHED; PG8_LDA(At, 1, 0); PG8_STAGE(PG8_SA(0, 1), a2 + hstep, voffA);
            PG8_WAIT_L(8); PG8_BAR; PG8_WAIT_L(0); PG8_MMA(0, 0, At, B0); PG8_BAR; PG8_SCHED;
            PG8_LDB(B1, 1, 1); PG8_STAGE(PG8_SB(1, 0), b3, voffB);
            PG8_BAR; PG8_WAIT_L(0); PG8_MMA(0, 1, At, B1); PG8_BAR;
            PG8_LDA(At, 1, 1); PG8_STAGE(PG8_SA(1, 0), a3, voffA);
            PG8_BAR; PG8_WAIT_L(0); PG8_MMA(1, 0, At, B0); PG8_BAR; PG8_SCHED;
            PG8_STAGE(PG8_SB(1, 1), b3 + hstep, voffB);
            PG8_WAIT_V(6); PG8_BAR; PG8_MMA(1, 1, At, B1); PG8_BAR;
            }
        }
        if constexpr (ALIGN_EPI) { if (wr == 0) PG8_BAR; }
        if constexpr (!Epi::AFTER_DRAIN) { E(acc, cur, wr, wc, fr, fq); S.done(cur); }
        if (!has_next) break;
#pragma unroll
        for (int a = 0; a < 2; ++a)
#pragma unroll
            for (int b = 0; b < 2; ++b)
#pragma unroll
                for (int m = 0; m < 4; ++m)
#pragma unroll
                    for (int n = 0; n < 2; ++n) acc[a][b][m][n] = (f32x4){0.f, 0.f, 0.f, 0.f};
        cur = nxt; cA = nA; cB = nB; ++ui;
        if constexpr (ALIGN_EPI) { if (wr == 1) PG8_BAR; }
    }
    PG8_WAIT_V(0);
    if constexpr (!ALIGN_EPI) { if (wr == 0) PG8_BAR; }
    PG8_BAR;
    if constexpr (Epi::AFTER_DRAIN) { E.fused(acc, cur, wr, wc, fr, fq, lds, wid, lane); S.done(cur); }
#undef PG8_SA
#undef PG8_SB
#undef PG8_STAGE
#undef PG8_LDA
#undef PG8_LDB
#undef PG8_MMA
#undef PG8_WAIT_V
#undef PG8_WAIT_L
#undef PG8_BAR
#undef PG8_SCHED
}
}
#ifndef EN_WCVT
#define EN_WCVT 1
#endif
#ifndef EN_GEMM
#define EN_GEMM 1
#endif
#ifndef EN_SCAL
#define EN_SCAL 1
#endif
#ifndef EN_PREP
#define EN_PREP 1
#endif
#ifndef EN_SCANFIN
#define EN_SCANFIN 1
#endif
#ifndef EN_SFA
#define EN_SFA 1
#endif
#ifndef EN_SFB
#define EN_SFB 1
#endif
#ifndef EN_SFC
#define EN_SFC 1
#endif
#ifndef PROBE_Q
#define PROBE_Q -1
#endif
#ifndef PROBE_REPS
#define PROBE_REPS 2
#endif
#ifndef PROBE_SCAL
#define PROBE_SCAL 1
#endif
#ifndef PROBE_SFA
#define PROBE_SFA 1
#endif
#ifndef PROBE_SFB
#define PROBE_SFB 1
#endif
#ifndef PROBE_SFC
#define PROBE_SFC 1
#endif
#ifndef PROBE_DN_W
#define PROBE_DN_W 1
#endif
#ifndef PROBE_DN_Q
#define PROBE_DN_Q 1
#endif
#ifndef PROBE_DN_BAR
#define PROBE_DN_BAR 1
#endif
#ifndef PROBE_DN_LOAD
#define PROBE_DN_LOAD 1
#endif
#ifndef PROBE_DP1
#define PROBE_DP1 1
#endif
#ifndef PROBE_DP3
#define PROBE_DP3 1
#endif
#ifndef PROBE_DP4
#define PROBE_DP4 1
#endif
#ifndef PROBE_PDN
#define PROBE_PDN 1
#endif
#ifndef PROBE_PRG
#define PROBE_PRG 1
#endif
#ifndef NORM_XBF
#define NORM_XBF 0
#endif
#ifndef PROBE_BAR
#define PROBE_BAR 1
#endif
#ifndef EN_NORM
#define EN_NORM 1
#endif
#ifndef MK_SINGLE
#define MK_SINGLE 1
#endif
constexpr int NWAVES = 8;

constexpr int DM = 1024, NB = 8, SEQ = 2048, NDB = 128, DSEQ = 8, DEPTH = 2;
constexpr int MP = NB * SEQ, MS = NDB * DSEQ, M = MP + MS;
constexpr int DFF = 2816, RGW = 512, DNH = 4, DHD = 128, CONVCH = 2048, NPROJ = 3072, INCOLS = 3080;
constexpr float EPS = 1e-6f;
constexpr size_t OFF_Y = 0, OFF_CP = 17825792, OFF_RP = 17924096, OFF_DP = 17932288, OFF_CS = 18980864, OFF_RS = 20553728, OFF_DS = 20684800, OUT_TOTAL = 37462016;
enum { I_XP = 0, I_XS, I_SCONV, I_SRG, I_SDN, I_F1PRE, I_F1UP, I_F1DN, I_F1POST, I_MPRE, I_WIN, I_CONVW, I_CONVB, I_RGWA, I_RGBA, I_RGWX, I_RGBX, I_LAM, I_ALOG, I_DTB, I_DNNW, I_WOUT, I_MPOST,
       I_F2PRE, I_F2UP, I_F2DN, I_F2POST, I_FINAL, N_IN };

constexpr size_t MiB = 1u << 20;
constexpr size_t WS_CTL = 0, CTL_ZERO_BYTES = 1 * MiB;
constexpr size_t WS_W = 2 * MiB;
constexpr size_t WO_UP1 = 0, WO_DN1 = 11534336, WO_WIN = 17301504, WO_WOUT = 23592960, WO_UP2 = 25690112, WO_DN2 = 37224448, WO_END = 42991616;
constexpr size_t WS_XN = 44 * MiB;
constexpr size_t WS_H = 78 * MiB;
constexpr size_t WS_D = 180 * MiB;
constexpr size_t WS_MIX = 248 * MiB;
constexpr size_t WS_SCAL = 282 * MiB;
constexpr size_t WS_XR = 283 * MiB;
constexpr size_t WS_END = 417 * MiB;
static_assert(WS_W + WO_END <= WS_XN && WS_XN + (size_t)M * DM * 2 <= WS_H && WS_H + (size_t)M * NPROJ * 2 <= WS_D && WS_D + (size_t)M * DM * 4 <= WS_MIX && WS_MIX + (size_t)M * DM * 2 <= WS_SCAL && WS_SCAL + (size_t)M * 32 <= WS_XR && WS_XR + (size_t)M * DM * 4 <= WS_END, "d_ws map");
constexpr size_t WS_DSLAB = WS_D + 34 * MiB;
constexpr int NSPLIT_DN = 11, NSPLIT_OUT = 4;
constexpr size_t WS_SST = 351 * MiB;
constexpr int CW_BAR = 4096;

constexpr int RING_BYTES = 131072;
constexpr int LDS_BYTES = 163840;
constexpr int LDSCTL_OFF = LDS_BYTES - 1024, MISC_OFF = LDSCTL_OFF + 320;
static_assert(MISC_OFF + 128 <= LDS_BYTES, "LDS map");

#define GAS __attribute__((address_space(1)))
#define LAS __attribute__((address_space(3)))
typedef unsigned short bf16;
typedef unsigned v4u __attribute__((ext_vector_type(4)));
typedef unsigned v2u __attribute__((ext_vector_type(2)));
typedef float f32x4 __attribute__((ext_vector_type(4)));
typedef GAS unsigned gu32;
typedef GAS unsigned long long gu64;
#define RLX_AGENT __ATOMIC_RELAXED, __HIP_MEMORY_SCOPE_AGENT
#define LDS_WAIT() asm volatile("s_waitcnt lgkmcnt(0)" ::: "memory")
#define VM_WAIT() asm volatile("s_waitcnt vmcnt(0)" ::: "memory")
#define LDS_BARRIER() do { asm volatile("s_waitcnt lgkmcnt(0)" ::: "memory"); __builtin_amdgcn_s_barrier(); asm volatile("" ::: "memory"); } while (0)
__device__ __forceinline__ unsigned f2bf(float f) { unsigned u = __builtin_bit_cast(unsigned, f); return (u + 0x7fffu + ((u >> 16) & 1u)) >> 16; }
__device__ __forceinline__ unsigned pk2(float lo, float hi) { return f2bf(lo) | (f2bf(hi) << 16); }
__device__ __forceinline__ float bf2f(bf16 v) { return __builtin_bit_cast(float, (unsigned)v << 16); }
__device__ __forceinline__ float sigmoid_f(float x) { return __builtin_amdgcn_rcpf(1.0f + __builtin_amdgcn_exp2f(-1.44269504089f * x)); }
__device__ __forceinline__ float silu_ff(float x) { return x * __builtin_amdgcn_rcpf(1.0f + __builtin_amdgcn_exp2f(-1.44269504089f * x)); }
__device__ __forceinline__ float silu_fast(float x) { return x * __builtin_amdgcn_rcpf(1.0f + __builtin_amdgcn_exp2f(-1.44269504089f * x)); }
__device__ __forceinline__ float softplus_f(float x) { return fmaxf(x, 0.0f) + log1pf(__expf(-fabsf(x))); }
__device__ __forceinline__ float gelu_tanh_f(float x) { const float u = 0.7978845608028654f * (x + 0.044715f * x * x * x); return x * sigmoid_f(2.0f * u); }
__device__ __forceinline__ float neg_expm1_f(float e) {
    const float p = -e * (1.0f + e * 0.5f * (1.0f + e * (1.0f / 3.0f) * (1.0f + e * 0.25f * (1.0f + e * 0.2f * (1.0f + e * (1.0f / 6.0f) * (1.0f + e * (1.0f / 7.0f)))))));
    return e > -0.25f ? p : 1.0f - __builtin_amdgcn_exp2f(1.44269504089f * e);
}
#define DPP_ADD(v, ctrl) ((v) + __builtin_bit_cast(float, __builtin_amdgcn_update_dpp(0, __builtin_bit_cast(int, (v)), (ctrl), 0xF, 0xF, true)))
__device__ __forceinline__ float row_sum8(float v) { v = DPP_ADD(v, 0xB1); v = DPP_ADD(v, 0x4E); v = DPP_ADD(v, 0x141); return v; }
__device__ __forceinline__ float row_sum16(float v) { v = row_sum8(v); v = DPP_ADD(v, 0x140); return v; }
__device__ __forceinline__ float wave_sum(float v) {
    v = row_sum16(v);
    const int iv = __builtin_bit_cast(int, v);
    return (__builtin_bit_cast(float, __builtin_amdgcn_readlane(iv, 0)) + __builtin_bit_cast(float, __builtin_amdgcn_readlane(iv, 16))) +
           (__builtin_bit_cast(float, __builtin_amdgcn_readlane(iv, 32)) + __builtin_bit_cast(float, __builtin_amdgcn_readlane(iv, 48)));
}

#define XB_TMO      128
#define XB_XCNT(j)  (256  + 64 * (j))
#define XB_XSUB(j)  (1280 + 64 * (j))
#define XB_XGEN(j)  (2304 + 64 * (j))
#define XB_TOP      3328
#define XB_TOPGEN   3392
#define XCD_BAR_WORDS 3456
#define XB_SPIN_CAP (1u << 18)

__device__ __forceinline__ unsigned xb_ld(unsigned* p)              { return __hip_atomic_load(p, __ATOMIC_RELAXED, __HIP_MEMORY_SCOPE_AGENT); }
__device__ __forceinline__ unsigned xb_add(unsigned* p, unsigned v) { return __hip_atomic_fetch_add(p, v, __ATOMIC_RELAXED, __HIP_MEMORY_SCOPE_AGENT); }
__device__ __forceinline__ unsigned xb_xcc_id() { return (unsigned)__builtin_amdgcn_s_getreg((3 << 11) | 20) & 0xFu; }
#define XB_SPIN(cond, bar) do { unsigned _sp = 0; while (cond) { __builtin_amdgcn_s_sleep(1); \
    if ((++_sp & 255u) == 0u) { if (xb_ld(&(bar)[XB_TMO])) break; if (_sp > XB_SPIN_CAP) { atomicAdd(&(bar)[XB_TMO], 1u); break; } } } } while (0)

struct XcdBarrier {
    unsigned* bar; unsigned x;
    volatile LAS unsigned* st;
};

__device__ __forceinline__ XcdBarrier xcd_barrier_post(unsigned* bar, volatile LAS unsigned* st) {
    XcdBarrier b; b.bar = bar; b.x = xb_xcc_id(); b.st = st;
    if (threadIdx.x == 0) (void)xb_add(&bar[XB_XCNT(b.x)], 1u);
    return b;
}
__device__ __forceinline__ void xcd_barrier_complete(unsigned* bar, unsigned x, unsigned& nloc, unsigned& nx) {
    const unsigned G = gridDim.x * gridDim.y * gridDim.z;
    unsigned sum, cnt, mine, sp = 0u;
    for (;;) {
        sum = 0u; cnt = 0u; mine = 0u;
#pragma unroll
        for (unsigned j = 0; j < 16; ++j) { const unsigned c = xb_ld(&bar[XB_XCNT(j)]); sum += c; cnt += (c > 0u) ? 1u : 0u; mine = (j == x) ? c : mine; }
        if (sum == G) break;
        __builtin_amdgcn_s_sleep(1);
        if ((++sp & 255u) == 0u) { if (xb_ld(&bar[XB_TMO])) break; if (sp > XB_SPIN_CAP) { atomicAdd(&bar[XB_TMO], 1u); break; } }
    }
    nloc = mine > 0u ? mine : 1u; nx = cnt > 0u ? cnt : 1u;
}

__device__ __forceinline__ void xcd_barrier(const XcdBarrier& b) {
    asm volatile("s_waitcnt vmcnt(0)" ::: "memory");
    __syncthreads();
    if (threadIdx.x == 0) {
        unsigned* bar = b.bar;
        __builtin_amdgcn_s_waitcnt(0);
        unsigned nloc = b.st[0], nx = b.st[1];
        if (nloc == 0u) { xcd_barrier_complete(bar, b.x, nloc, nx); b.st[0] = nloc; b.st[1] = nx; }
        const unsigned old = xb_add(&bar[XB_XSUB(b.x)], 1u);
        const unsigned gen = old / nloc;
        if (old + 1u == (gen + 1u) * nloc) {
            __builtin_amdgcn_fence(__ATOMIC_RELEASE, "agent");
            asm volatile("s_waitcnt vmcnt(0)" ::: "memory");
            const unsigned og = xb_add(&bar[XB_TOP], 1u);
            const unsigned tg = og / nx;
            if (og + 1u == (tg + 1u) * nx) xb_add(&bar[XB_TOPGEN], 1u);
            else XB_SPIN(xb_ld(&bar[XB_TOPGEN]) == tg, bar);
            __builtin_amdgcn_fence(__ATOMIC_ACQUIRE, "agent");
            xb_add(&bar[XB_XGEN(b.x)], 1u);
            asm volatile("s_waitcnt vmcnt(0)" ::: "memory");
        } else {
            XB_SPIN(xb_ld(&bar[XB_XGEN(b.x)]) == gen, bar);
            __builtin_amdgcn_fence(__ATOMIC_ACQUIRE, "agent");
            asm volatile("s_waitcnt vmcnt(0)" ::: "memory");
        }
    }
    __syncthreads();
}


struct Args { const float* in[N_IN]; float* out; unsigned char* ws; int ph_lo, ph_hi; };

__device__ __forceinline__ void transpose_item(const float* W, int ldn, int K, bf16* WT, int k0, int n0, int drow0, LAS float* scr, int lane) {
#pragma unroll 8
    for (int i = 0; i < 32; ++i) { const int kk = 2 * i + (lane >> 5); scr[kk * 33 + (lane & 31)] = W[(size_t)(k0 + kk) * ldn + n0 + (lane & 31)]; }
    LDS_WAIT(); asm volatile("" ::: "memory");
    const int c = lane & 7;
#pragma unroll
    for (int j = 0; j < 4; ++j) { const int n = (lane >> 3) + 8 * j; const LAS float* s = scr + (8 * c) * 33 + n;
        v4u o; o.x = pk2(s[0 * 33], s[1 * 33]); o.y = pk2(s[2 * 33], s[3 * 33]); o.z = pk2(s[4 * 33], s[5 * 33]); o.w = pk2(s[6 * 33], s[7 * 33]);
        *(GAS v4u*)(WT + (size_t)(drow0 + n) * K + k0 + 8 * c) = o; }
    LDS_WAIT(); asm volatile("" ::: "memory");
}
__device__ __forceinline__ int map_up_row(int n) { return n < DFF ? ((n >> 7) << 8) + (n & 127) : (((n - DFF) >> 7) << 8) + 128 + ((n - DFF) & 127); }

constexpr int WI_UP = 16 * 176, WI_DN = 44 * 32, WI_IN = 16 * 96, WI_OUT = 16 * 32;
constexpr int WI_0 = 0, WI_1 = WI_UP + WI_DN  , WI_2 = WI_1 + WI_IN  , WI_3 = WI_2 + WI_OUT + WI_UP + WI_DN  ;
__device__ __forceinline__ void wcvt_range(const Args& a, int l, int it_lo, int it_hi, int worker, int nworkers, LAS unsigned char* lds, int wave, int lane) {
    LAS float* scr = (LAS float*)(lds + wave * 16384);
    bf16* wbase = (bf16*)(a.ws + WS_W);
    constexpr int I_UP = WI_UP, I_DN = WI_DN, I_IN = WI_IN, I_OUT = WI_OUT;
    for (int it = it_lo + worker; it < it_hi; it += nworkers) {
        int r = it; const float* W; int ldn, K, nblk; size_t wo; bool up = false;
        if (r < I_UP) { W = a.in[I_F1UP] + (size_t)l * DM * 2 * DFF; ldn = 2 * DFF; K = DM; nblk = 176; wo = WO_UP1; up = true; }
        else if ((r -= I_UP) < I_DN) { W = a.in[I_F1DN] + (size_t)l * DFF * DM; ldn = DM; K = DFF; nblk = 32; wo = WO_DN1; }
        else if ((r -= I_DN) < I_IN) { W = a.in[I_WIN] + (size_t)l * DM * INCOLS; ldn = INCOLS; K = DM; nblk = 96; wo = WO_WIN; }
        else if ((r -= I_IN) < I_OUT) { W = a.in[I_WOUT] + (size_t)l * DM * DM; ldn = DM; K = DM; nblk = 32; wo = WO_WOUT; }
        else if ((r -= I_OUT) < I_UP) { W = a.in[I_F2UP] + (size_t)l * DM * 2 * DFF; ldn = 2 * DFF; K = DM; nblk = 176; wo = WO_UP2; up = true; }
        else { r -= I_UP; W = a.in[I_F2DN] + (size_t)l * DFF * DM; ldn = DM; K = DFF; nblk = 32; wo = WO_DN2; }
        const int kb = r / nblk, nb = r % nblk, n0 = 32 * nb;
        transpose_item(W, ldn, K, (bf16*)((unsigned char*)wbase + wo), 64 * kb, n0, up ? map_up_row(n0) : n0, scr, lane);
    }
}

__device__ __forceinline__ const float* x_in_row(const Args& a, int m) { return m < MP ? a.in[I_XP] + (size_t)m * DM : a.in[I_XS] + (size_t)(m - MP) * DM; }

__device__ __forceinline__ void xn0_phase(const Args& a, int wave, int lane) {
    const int gw = blockIdx.x * NWAVES + wave, NGW = gridDim.x * NWAVES;
    const float* g = a.in[I_F1PRE];
    f32x4 gv[4];
#pragma unroll
    for (int j = 0; j < 4; ++j) gv[j] = ((const f32x4*)g)[lane + 64 * j];
    for (int m = gw; m < M; m += NGW) {
        const f32x4* xr = (const f32x4*)x_in_row(a, m) + lane;
        f32x4 v[4]; float s = 0.f;
#pragma unroll
        for (int j = 0; j < 4; ++j) { v[j] = xr[64 * j]; s += (v[j].x * v[j].x + v[j].y * v[j].y) + (v[j].z * v[j].z + v[j].w * v[j].w); }
        const float rstd = rsqrtf(wave_sum(s) * (1.0f / DM) + EPS);
        unsigned long long* o8 = (unsigned long long*)((bf16*)(a.ws + WS_XN) + (size_t)m * DM) + lane;
#pragma unroll
        for (int j = 0; j < 4; ++j) { const f32x4 y = v[j] * rstd * gv[j]; o8[64 * j] = (unsigned long long)pk2(y.x, y.y) | ((unsigned long long)pk2(y.z, y.w) << 32); }
    }
}

__device__ __forceinline__ f32x4 bf4_to_f32(v2u w) { return (f32x4){__builtin_bit_cast(float, w.x << 16), __builtin_bit_cast(float, w.x & 0xffff0000u), __builtin_bit_cast(float, w.y << 16), __builtin_bit_cast(float, w.y & 0xffff0000u)}; }
__device__ __forceinline__ void norm_phase(const Args& a, const float* gpost, const float* gnext, float alpha, int kn, bool last, int nsplit, int wave, int lane) {
    const int gw = blockIdx.x * NWAVES + wave, NGW = gridDim.x * NWAVES;
    f32x4 gp[4], gn[4];
#pragma unroll
    for (int j = 0; j < 4; ++j) { gp[j] = ((const f32x4*)gpost)[lane + 64 * j]; gn[j] = ((const f32x4*)gnext)[lane + 64 * j]; }
    const bf16* D = (const bf16*)(a.ws + WS_D);
    const float* xsrc = (kn & 1) ? (const float*)(a.ws + WS_XR) : a.out + OFF_Y;
    float* xdst = (kn & 1) ? a.out + OFF_Y : (float*)(a.ws + WS_XR);
#if NORM_XBF
    const bf16* xsb = (const bf16*)(a.ws + WS_XR) + (size_t)(kn & 1) * M * DM;
    bf16* xdb = (bf16*)(a.ws + WS_XR) + (size_t)((kn + 1) & 1) * M * DM;
#endif
    constexpr int NR = 4;
    for (int m0 = gw; m0 < M; m0 += NR * NGW) {
        f32x4 d[NR][4], x[NR][4]; float s[NR];
#pragma unroll
        for (int rr = 0; rr < NR; ++rr) { const int m = m0 + rr * NGW; s[rr] = 0.f;
            if (m < M) {
                const v2u* dr = (const v2u*)(D + (size_t)m * DM) + lane;
                const f32x4* xr = (kn == 0 ? (const f32x4*)x_in_row(a, m) : (const f32x4*)(xsrc + (size_t)m * DM)) + lane;
#pragma unroll
                for (int j = 0; j < 4; ++j) {
#if NORM_XBF
                    x[rr][j] = kn == 0 ? xr[64 * j] : bf4_to_f32(((const v2u*)(xsb + (size_t)m * DM) + lane)[64 * j]);
#else
                    x[rr][j] = xr[64 * j];
#endif
                    if (m < MP) d[rr][j] = bf4_to_f32(dr[64 * j]);
                    else { d[rr][j] = (f32x4){0.f, 0.f, 0.f, 0.f};
                        for (int sp = 0; sp < nsplit; ++sp) d[rr][j] += bf4_to_f32(((const v2u*)((const bf16*)(a.ws + WS_DSLAB) + ((size_t)sp * MS + (m - MP)) * DM) + lane)[64 * j]); }
                    s[rr] += (d[rr][j].x * d[rr][j].x + d[rr][j].y * d[rr][j].y) + (d[rr][j].z * d[rr][j].z + d[rr][j].w * d[rr][j].w); } } }
#pragma unroll
        for (int rr = 0; rr < NR; ++rr) { const int m = m0 + rr * NGW;
            if (m < M) {
                const float rs = alpha * rsqrtf(wave_sum(s[rr]) * (1.0f / DM) + EPS);
                float s2 = 0.f;
#pragma unroll
                for (int j = 0; j < 4; ++j) { x[rr][j] = x[rr][j] + d[rr][j] * rs * gp[j]; s2 += (x[rr][j].x * x[rr][j].x + x[rr][j].y * x[rr][j].y) + (x[rr][j].z * x[rr][j].z + x[rr][j].w * x[rr][j].w); }
                const float rs2 = rsqrtf(wave_sum(s2) * (1.0f / DM) + EPS);
                f32x4* xo = (f32x4*)((NORM_XBF && last ? a.out + OFF_Y : xdst) + (size_t)m * DM) + lane;
                if (last) {
#pragma unroll
                    for (int j = 0; j < 4; ++j) xo[64 * j] = x[rr][j] * rs2 * gn[j];
                } else {
                    v2u* o8 = (v2u*)((bf16*)(a.ws + WS_XN) + (size_t)m * DM) + lane;
#pragma unroll
                    for (int j = 0; j < 4; ++j) {
#if NORM_XBF
                        { v2u xw; xw.x = pk2(x[rr][j].x, x[rr][j].y); xw.y = pk2(x[rr][j].z, x[rr][j].w); ((v2u*)(xdb + (size_t)m * DM) + lane)[64 * j] = xw; }
#else
                        xo[64 * j] = x[rr][j];
#endif
                        const f32x4 y = x[rr][j] * rs2 * gn[j]; v2u yw; yw.x = pk2(y.x, y.y); yw.y = pk2(y.z, y.w); o8[64 * j] = yw; }
                }
            } }
    }
}

__device__ __forceinline__ void scal_phase(const Args& a, int l, LAS unsigned char* lds, int tid, int wave, int lane) {
    const int gw = blockIdx.x * NWAVES + wave, NGW = gridDim.x * NWAVES;
    const float* wl = a.in[I_WIN] + (size_t)l * DM * INCOLS + NPROJ;
    LAS float* wsm = (LAS float*)lds;
#pragma unroll
    for (int n = 0; n < 4; ++n) { const int p = tid + 512 * n; *(LAS f32x4*)(wsm + 4 * p + 4 * (p >> 4)) = *(const f32x4*)(wl + (size_t)(p >> 1) * INCOLS + 4 * (p & 1)); }
    __syncthreads();
    const bf16* XN = (const bf16*)(a.ws + WS_XN);
    float* SC = (float*)(a.ws + WS_SCAL);
    for (int m = gw; m < M; m += NGW) {
        float acc[8];
#pragma unroll
        for (int j = 0; j < 8; ++j) acc[j] = 0.f;
#pragma unroll
        for (int jj = 0; jj < 2; ++jj) {
            const int k0 = 8 * lane + 512 * jj;
            const v4u x0 = *(const v4u*)(XN + (size_t)m * DM + k0);
            const unsigned xw[4] = {x0.x, x0.y, x0.z, x0.w};
#pragma unroll
            for (int i = 0; i < 8; ++i) {
                const float xv = (i & 1) ? __builtin_bit_cast(float, xw[i >> 1] & 0xffff0000u) : __builtin_bit_cast(float, xw[i >> 1] << 16);
                const f32x4 w0 = *(const LAS f32x4*)(wsm + (k0 + i) * 8 + (k0 >> 1)), w1 = *(const LAS f32x4*)(wsm + (k0 + i) * 8 + (k0 >> 1) + 4);
                acc[0] += xv * w0.x; acc[1] += xv * w0.y; acc[2] += xv * w0.z; acc[3] += xv * w0.w;
                acc[4] += xv * w1.x; acc[5] += xv * w1.y; acc[6] += xv * w1.z; acc[7] += xv * w1.w;
            }
        }
#pragma unroll
        for (int j = 0; j < 8; ++j) acc[j] = wave_sum(acc[j]);
        if (lane == 0) { f32x4* o = (f32x4*)(SC + (size_t)m * 8); o[0] = (f32x4){acc[0], acc[1], acc[2], acc[3]}; o[1] = (f32x4){acc[4], acc[5], acc[6], acc[7]}; }
    }
    __syncthreads();
}

__device__ __forceinline__ float conv_src(const Args& a, int l, int m, int ch, int back) {
    const bf16* PROJ = (const bf16*)(a.ws + WS_H);
    const int t = m < MP ? (m & (SEQ - 1)) : ((m - MP) & (DSEQ - 1));
    const int ts = t - back;
    if (ts >= 0) return bf2f(PROJ[(size_t)(m - back) * NPROJ + ch]);
    if (m < MP) return 0.f;
    const int bs = (m - MP) >> 3;
    return a.in[I_SCONV][((size_t)(l * NDB + bs) * 3 + (3 + ts)) * CONVCH + ch];
}

__device__ __forceinline__ void delta_seq(const Args& a, int l, int item, LAS unsigned char* lds, int tid) {
    asm volatile("" : "+v"(tid));
    LAS float* qs = (LAS float*)lds;
    LAS float* ks = qs + 256;
    LAS float* red = ks + 256;
    LAS float* red2 = red + 16;
    const int bs = item >> 1, hl = __builtin_amdgcn_readfirstlane(tid >> 8), h = 2 * (item & 1) + hl, e = (tid & 255) >> 1, half = tid & 1, lane = tid & 63, wave = __builtin_amdgcn_readfirstlane(tid >> 6);
    const int m0 = MP + bs * DSEQ, chq = 512 + h * 128 + e;
    float s[64];
    { const float* S0 = a.in[I_SDN] + (((size_t)(l * NDB + bs) * DNH + h) << 14) + (size_t)(64 * half) * 128 + e;
#pragma unroll
      for (int d = 0; d < 64; ++d) s[d] = S0[d * 128]; }
    const float* cw = a.in[I_CONVW] + (size_t)l * 4 * CONVCH;
    float wq[4], wk[4], wv[4], hq[3], hk[3], hv[3];
#pragma unroll
    for (int t = 0; t < 4; ++t) { wq[t] = cw[t * CONVCH + chq]; wk[t] = cw[t * CONVCH + 512 + chq]; wv[t] = cw[t * CONVCH + 1024 + chq]; }
#pragma unroll
    for (int r = 0; r < 3; ++r) { const float* sc = a.in[I_SCONV] + ((size_t)(l * NDB + bs) * 3 + r) * CONVCH; hq[r] = sc[chq]; hk[r] = sc[512 + chq]; hv[r] = sc[1024 + chq]; }
    const float negA = -__expf(a.in[I_ALOG][l * DNH + h]), dtb = a.in[I_DTB][l * DNH + h], nw = a.in[I_DNNW][l * DHD + e];
    const bf16* PROJ = (const bf16*)(a.ws + WS_H); const float* SC = (const float*)(a.ws + WS_SCAL); bf16* MIX = (bf16*)(a.ws + WS_MIX);
    for (int t = 0; t < DSEQ; ++t) {
        const int m = m0 + t; const bf16* prow = PROJ + (size_t)m * NPROJ;
        const float xq = bf2f(prow[chq]), xk = bf2f(prow[512 + chq]), xv = bf2f(prow[1024 + chq]), z = bf2f(prow[2048 + chq]);
        const float sb = SC[(size_t)m * 8 + h], sg = SC[(size_t)m * 8 + 4 + h];
        const float cq = wq[0] * hq[0] + wq[1] * hq[1] + wq[2] * hq[2] + wq[3] * xq; hq[0] = hq[1]; hq[1] = hq[2]; hq[2] = xq;
        const float ck = wk[0] * hk[0] + wk[1] * hk[1] + wk[2] * hk[2] + wk[3] * xk; hk[0] = hk[1]; hk[1] = hk[2]; hk[2] = xk;
        const float cv = wv[0] * hv[0] + wv[1] * hv[1] + wv[2] * hv[2] + wv[3] * xv; hv[0] = hv[1]; hv[1] = hv[2]; hv[2] = xv;
        const float sq_ = silu_ff(cq), sk = silu_ff(ck), sv = silu_ff(cv);
        const float ssq = wave_sum(half ? 0.f : sq_ * sq_), ssk = wave_sum(half ? 0.f : sk * sk);
        if (lane == 0) { red[wave * 2] = ssq; red[wave * 2 + 1] = ssk; }
        LDS_BARRIER();
        const float tq = (red[8 * hl] + red[8 * hl + 2]) + (red[8 * hl + 4] + red[8 * hl + 6]), tk = (red[8 * hl + 1] + red[8 * hl + 3]) + (red[8 * hl + 5] + red[8 * hl + 7]);
        if (!half) { qs[hl * 128 + e] = sq_ * rsqrtf(tq + EPS) * 0.08838834764831845f; ks[hl * 128 + e] = sk * rsqrtf(tk + EPS); }
        LDS_BARRIER();
        const float beta = sigmoid_f(sb), eg = __expf(negA * softplus_f(sg + dtb));
        const LAS float* kh = ks + hl * 128 + 64 * half; const LAS float* qh = qs + hl * 128 + 64 * half;
        float dot = 0.f;
#pragma unroll
        for (int d = 0; d < 64; d += 4) { const f32x4 k4 = *(const LAS f32x4*)(kh + d); dot += k4.x * s[d] + k4.y * s[d + 1] + k4.z * s[d + 2] + k4.w * s[d + 3]; }
        dot += __shfl_xor(dot, 1);
        const float c = beta * (sv - eg * dot);
        float o = 0.f;
#pragma unroll
        for (int d = 0; d < 64; d += 4) { const f32x4 k4 = *(const LAS f32x4*)(kh + d); const f32x4 q4 = *(const LAS f32x4*)(qh + d);
            s[d] = eg * s[d] + k4.x * c; s[d + 1] = eg * s[d + 1] + k4.y * c; s[d + 2] = eg * s[d + 2] + k4.z * c; s[d + 3] = eg * s[d + 3] + k4.w * c;
            o += q4.x * s[d] + q4.y * s[d + 1] + q4.z * s[d + 2] + q4.w * s[d + 3]; }
        o += __shfl_xor(o, 1);
        const float sso = wave_sum(half ? 0.f : o * o);
        if (lane == 0) red2[wave] = sso;
        LDS_BARRIER();
        const float rstd = rsqrtf(((red2[4 * hl] + red2[4 * hl + 1]) + (red2[4 * hl + 2] + red2[4 * hl + 3])) * (1.0f / DHD) + EPS);
        if (!half) MIX[(size_t)m * DM + chq] = (bf16)f2bf(o * rstd * nw * silu_ff(z));
    }
    float* So = a.out + OFF_DS + (((size_t)(l * NDB + bs) * DNH + h) << 14) + (size_t)(64 * half) * 128 + e;
#pragma unroll
    for (int d = 0; d < 64; ++d) So[d * 128] = s[d];
    LDS_BARRIER();
}

constexpr size_t DI_W = WS_D, DI_QG = WS_D + 16 * MiB, DI_KGT = WS_D + 32 * MiB, DI_U = WS_D + 48 * MiB, DI_ATT = WS_XN, DI_EGL = WS_XN + 8 * MiB;
typedef short bf16x8v __attribute__((ext_vector_type(8)));
typedef float f32x2_t __attribute__((ext_vector_type(2)));
typedef __bf16 bf16x2_t __attribute__((ext_vector_type(2)));
__device__ __forceinline__ unsigned cvtpk_s(float lo, float hi) { f32x2_t v = {lo, hi}; bf16x2_t b = __builtin_convertvector(v, bf16x2_t); return __builtin_bit_cast(unsigned, b); }
__device__ __forceinline__ bf16x8v pack8(const f32x4 lo4, const f32x4 hi4) { v4u w; w.x = cvtpk_s(lo4[0], lo4[1]); w.y = cvtpk_s(lo4[2], lo4[3]); w.z = cvtpk_s(hi4[0], hi4[1]); w.w = cvtpk_s(hi4[2], hi4[3]); return __builtin_bit_cast(bf16x8v, w); }
__device__ __forceinline__ int perm32k(int x) { return 8 * ((x >> 2) & 3) + 4 * (x >> 4) + (x & 3); }

constexpr int VBSTR = 136, RAWSTR = 392;
constexpr int DP_QB = 0, DP_KB = 17408, DP_VB = 34816, DP_AM = 52224, DP_RAW = 52224, DP_GS = DP_RAW + 67 * RAWSTR * 2, DP_BS = DP_GS + 256, DP_CW = DP_BS + 256, DP_END = DP_CW + 6144;
static_assert(DP_VB + 64 * VBSTR * 2 <= DP_AM && DP_END <= LDSCTL_OFF && DP_GS % 16 == 0, "DNPREP LDS map");
__device__ __forceinline__ void dnprep_item(const Args& a, int l, int it, LAS unsigned char* lds, int tid) {
    asm volatile("" : "+v"(tid));
    LAS bf16* qb = (LAS bf16*)(lds + DP_QB);
    LAS bf16* kb = (LAS bf16*)(lds + DP_KB);
    LAS bf16* vb = (LAS bf16*)(lds + DP_VB);
    LAS float* Am = (LAS float*)(lds + DP_AM);
    LAS bf16* raw = (LAS bf16*)(lds + DP_RAW);
    LAS float* Gs = (LAS float*)(lds + DP_GS);
    LAS float* bs = (LAS float*)(lds + DP_BS);
    LAS float* cw = (LAS float*)(lds + DP_CW);
    const int lane = tid & 63, wave = __builtin_amdgcn_readfirstlane(tid >> 6), q4 = lane >> 4, r16 = lane & 15;
    const int c = it & 31, h = (it >> 5) & 3, b = it >> 7;
    const bf16* PROJ = (const bf16*)(a.ws + WS_H);
    const int mbase = b * SEQ + 64 * c;
    {
        v4u pv[7];
#pragma unroll
        for (int n = 0; n < 7; ++n) { const int p = tid + 512 * n; pv[n] = (v4u){0u, 0u, 0u, 0u};
            if (p < 67 * 48) { const int slot = p / 48, pc = p - slot * 48;
                if (64 * c + slot - 3 >= 0) pv[n] = *(const v4u*)(PROJ + (size_t)(mbase - 3 + slot) * NPROJ + 512 * (1 + (pc >> 4)) + 128 * h + 8 * (pc & 15)); } }
        f32x4 wv = (f32x4){0.f, 0.f, 0.f, 0.f};
        if (tid < 384) { const int which = tid >> 7, tap = (tid >> 5) & 3, f4 = tid & 31; wv = *(const f32x4*)(a.in[I_CONVW] + ((size_t)l * 4 + tap) * CONVCH + 512 * (1 + which) + 128 * h + 4 * f4); }
        if (wave == 0) {
            const float* SC = (const float*)(a.ws + WS_SCAL) + (size_t)(mbase + lane) * 8;
            const float beta = sigmoid_f(SC[h]);
            float G = -__expf(a.in[I_ALOG][l * DNH + h]) * softplus_f(SC[4 + h] + a.in[I_DTB][l * DNH + h]);
#pragma unroll
            for (int off = 1; off < 64; off <<= 1) { const float tt = __shfl_up(G, off); if (lane >= off) G += tt; }
            Gs[lane] = G; bs[lane] = beta;
            if (lane == 63) ((float*)(a.ws + DI_EGL))[it] = __expf(G);
        }
#pragma unroll
        for (int n = 0; n < 7; ++n) { const int p = tid + 512 * n; if (p < 67 * 48) { const int slot = p / 48, pc = p - slot * 48; *(LAS v4u*)(raw + slot * RAWSTR + 8 * pc) = pv[n]; } }
        if (tid < 384) *(LAS f32x4*)(cw + 4 * tid) = wv;
    }
    LDS_BARRIER();
    _Pragma("unroll 1") for (int pr1 = 0; pr1 < PROBE_DP1; ++pr1) {
        const int i = tid >> 3, sub = tid & 7;
#pragma unroll
        for (int which = 0; which < 3; ++which) {
            float o[16];
#pragma unroll
            for (int x = 0; x < 16; ++x) o[x] = 0.f;
#pragma unroll
            for (int tap = 0; tap < 4; ++tap) {
                const LAS v4u* xp = (const LAS v4u*)(raw + (i + tap) * RAWSTR + which * 128 + 16 * sub);
                const v4u x0 = xp[0], x1 = xp[1];
                const LAS f32x4* wp = (const LAS f32x4*)(cw + (which * 4 + tap) * 128 + 16 * sub);
                const f32x4 w0 = wp[0], w1 = wp[1], w2 = wp[2], w3 = wp[3];
                const unsigned xw[8] = {x0.x, x0.y, x0.z, x0.w, x1.x, x1.y, x1.z, x1.w};
                const float wv[16] = {w0.x, w0.y, w0.z, w0.w, w1.x, w1.y, w1.z, w1.w, w2.x, w2.y, w2.z, w2.w, w3.x, w3.y, w3.z, w3.w};
#pragma unroll
                for (int x = 0; x < 16; ++x) { const float xv = (x & 1) ? __builtin_bit_cast(float, xw[x >> 1] & 0xffff0000u) : __builtin_bit_cast(float, xw[x >> 1] << 16); o[x] += wv[x] * xv; }
            }
            float ss = 0.f;
#pragma unroll
            for (int x = 0; x < 16; ++x) { o[x] = silu_ff(o[x]); ss += o[x] * o[x]; }
            ss = row_sum8(ss);
            const float sc = which == 0 ? __builtin_amdgcn_rsqf(ss + EPS) * 0.08838834764831845f : (which == 1 ? __builtin_amdgcn_rsqf(ss + EPS) : 1.0f);
            v4u w0, w1; w0.x = cvtpk_s(o[0] * sc, o[1] * sc); w0.y = cvtpk_s(o[2] * sc, o[3] * sc); w0.z = cvtpk_s(o[4] * sc, o[5] * sc); w0.w = cvtpk_s(o[6] * sc, o[7] * sc);
            w1.x = cvtpk_s(o[8] * sc, o[9] * sc); w1.y = cvtpk_s(o[10] * sc, o[11] * sc); w1.z = cvtpk_s(o[12] * sc, o[13] * sc); w1.w = cvtpk_s(o[14] * sc, o[15] * sc);
            LAS v4u* dst = (LAS v4u*)((which == 0 ? qb : (which == 1 ? kb : vb)) + i * VBSTR + 16 * sub); dst[0] = w0; dst[1] = w1;
            asm volatile("" ::: "memory");
        }
    }
    LDS_BARRIER();
    bf16* ATT = (bf16*)(a.ws + DI_ATT) + (size_t)it * 4096;
    _Pragma("unroll 1") for (int pr3 = 0; pr3 < PROBE_DP3; ++pr3)
    for (int jb = wave; jb < 26; jb += 8) {
        if (jb >= 20) {
            const int z = jb - 20, ti = z < 3 ? 0 : (z < 5 ? 1 : 2), tj = z < 3 ? z + 1 : (z < 5 ? z - 1 : 3);
#pragma unroll
            for (int r = 0; r < 4; ++r) { const int i = 16 * ti + 4 * q4 + r, j = 16 * tj + r16; ATT[i * 64 + (j & 32) + perm32k(j & 31)] = (bf16)0; }
            continue;
        }
        const bool iskk = jb < 10; const int jl = iskk ? jb : jb - 10;
        const int ti = jl >= 6 ? 3 : (jl >= 3 ? 2 : (jl >= 1 ? 1 : 0)), tj = jl - (ti * (ti + 1)) / 2;
        const LAS bf16* X = (iskk ? kb : qb) + (16 * ti + r16) * VBSTR + 8 * q4;
        const LAS bf16* Kp = kb + (16 * tj + r16) * VBSTR + 8 * q4;
        bf16x8v xa[4], kf[4];
#pragma unroll
        for (int kk = 0; kk < 4; ++kk) { xa[kk] = *(const LAS bf16x8v*)(X + 32 * kk); kf[kk] = *(const LAS bf16x8v*)(Kp + 32 * kk); }
        f32x4 acc = (f32x4){0.f, 0.f, 0.f, 0.f};
#pragma unroll
        for (int kk = 0; kk < 4; ++kk) acc = __builtin_amdgcn_mfma_f32_16x16x32_bf16(xa[kk], kf[kk], acc, 0, 0, 0);
        const int j = 16 * tj + r16; const float Gj = Gs[j];
#pragma unroll
        for (int r = 0; r < 4; ++r) { const int i = 16 * ti + 4 * q4 + r;
            const float dec = __expf(i >= j ? Gs[i] - Gj : 0.f);
            if (iskk) Am[(j & 1) * 2048 + i * 32 + (j >> 1)] = i > j ? bs[i] * acc[r] * dec : 0.f;
            else ATT[i * 64 + (j & 32) + perm32k(j & 31)] = (bf16)f2bf(i >= j ? acc[r] * dec : 0.f); }
    }
    LDS_BARRIER();
    {
        const int half = tid & 1, cidx = tid >> 1, cc = cidx & 127; const bool isu = __builtin_amdgcn_readfirstlane(tid >> 8) == 0;
        const LAS float* Ah = Am + half * 2048;
        float sol[32], rhs[32];
        if (isu) {
#pragma unroll
            for (int ii = 0; ii < 32; ++ii) { const int i = 2 * ii + half; rhs[ii] = bf2f(vb[i * VBSTR + cc]) * bs[i]; }
        } else {
#pragma unroll
            for (int ii = 0; ii < 32; ++ii) { const int i = 2 * ii + half; rhs[ii] = bf2f(kb[i * VBSTR + cc]) * __expf(Gs[i]) * bs[i]; }
        }
#pragma unroll
        for (int x = 0; x < 32; ++x) sol[x] = 0.f;
#pragma unroll
        for (int i = 0; i < 64; ++i) {
            float part = 0.f;
#pragma unroll
            for (int j4 = 0; 4 * j4 < (i + 1) / 2; ++j4) { const f32x4 a4 = *(const LAS f32x4*)(Ah + i * 32 + 4 * j4);
                part += a4.x * sol[4 * j4] + a4.y * sol[4 * j4 + 1] + a4.z * sol[4 * j4 + 2] + a4.w * sol[4 * j4 + 3]; }
            part += __builtin_bit_cast(float, __builtin_amdgcn_update_dpp(0, __builtin_bit_cast(int, part), 0xB1, 0xF, 0xF, true));
            const float s = rhs[i >> 1] - part;
            sol[i >> 1] = ((i & 1) == half) ? s : sol[i >> 1];
            asm volatile("" ::: "memory");
        }
        bf16* dst = (isu ? (bf16*)(a.ws + DI_U) + (size_t)it * 8192 + cc : (bf16*)(a.ws + DI_W) + (size_t)it * 8192 + (cc & 96) + perm32k(cc & 31)) + half * 128;
#pragma unroll
        for (int ii = 0; ii < 32; ++ii) dst[ii * 256] = (bf16)f2bf(sol[ii]);
    }
    {
        bf16* QG = (bf16*)(a.ws + DI_QG) + (size_t)it * 8192; bf16* KGT = (bf16*)(a.ws + DI_KGT) + (size_t)it * 8192; const float G63 = Gs[63];
#pragma unroll
        for (int n = 0; n < 2; ++n) { const int p = tid + 512 * n;
            { const int i = p >> 4, g32 = (p >> 2) & 3, q = p & 3; const float eg = __expf(Gs[i]);
              const v2u lo2 = *(const LAS v2u*)(qb + i * VBSTR + 32 * g32 + 4 * q), hi2 = *(const LAS v2u*)(qb + i * VBSTR + 32 * g32 + 16 + 4 * q);
              *(v4u*)(QG + i * 128 + 32 * g32 + 8 * q) = __builtin_bit_cast(v4u, pack8(bf4_to_f32(lo2) * eg, bf4_to_f32(hi2) * eg)); }
            { const int dd = p >> 3, g32 = (p >> 2) & 1, q = p & 3;
              f32x4 lo, hi;
#pragma unroll
              for (int x = 0; x < 4; ++x) { const int t0 = 32 * g32 + 4 * q + x, t1 = t0 + 16; lo[x] = bf2f(kb[t0 * VBSTR + dd]) * __expf(G63 - Gs[t0]); hi[x] = bf2f(kb[t1 * VBSTR + dd]) * __expf(G63 - Gs[t1]); }
              *(v4u*)(KGT + dd * 64 + 32 * g32 + 8 * q) = __builtin_bit_cast(v4u, pack8(lo, hi)); } }
    }
    LDS_BARRIER();
}

constexpr int DNB_W = 0, DNB_QG = 16384, DNB_KGT = 32768, DNB_ATT = 49152, DNB_BYTES = 57344, DNB_U = 2 * DNB_BYTES, DNB_O = DNB_U + 16384, OSTR = 136, DNB_END = DNB_O + 64 * OSTR * 2;
static_assert(DNB_END <= LDSCTL_OFF, "DNSCAN LDS map");
__device__ __forceinline__ void dnscan_wg(const Args& a, int l, int bh, int c0, int c1, LAS unsigned char* lds, int tid) {
    const int lane = tid & 63, wave = __builtin_amdgcn_readfirstlane(tid >> 6), q4 = lane >> 4, r16 = lane & 15;
    const int b = bh >> 2, h = bh & 3;
    const bf16* PROJ = (const bf16*)(a.ws + WS_H); bf16* MIX = (bf16*)(a.ws + WS_MIX);
    if (wave < 4) {
        f32x4 S[2][8];
        f32x4* sst = (f32x4*)(a.ws + WS_SST) + (size_t)bh * 16 * 256 + tid;
#pragma unroll
        for (int ct = 0; ct < 2; ++ct)
#pragma unroll
            for (int j = 0; j < 8; ++j) S[ct][j] = c0 > 0 ? sst[256 * (8 * ct + j)] : (f32x4){0.f, 0.f, 0.f, 0.f};
        int fA[4], fB[2];
#pragma unroll
        for (int kk = 0; kk < 4; ++kk) fA[kk] = r16 * 256 + (((4 * kk + q4) ^ r16) << 4);
#pragma unroll
        for (int k2 = 0; k2 < 2; ++k2) fB[k2] = r16 * 128 + (((4 * k2 + q4) ^ ((r16 >> 1) & 7)) << 4);
        int uoff[2][4];
#pragma unroll
        for (int ct = 0; ct < 2; ++ct)
#pragma unroll
            for (int r = 0; r < 4; ++r) uoff[ct][r] = (4 * q4) * 256 + ((((4 * wave + 2 * ct + (r16 >> 3)) ^ ((4 * q4 + r) & 15))) << 4) + 2 * (r16 & 7);
        LAS bf16* obase = (LAS bf16*)(lds + DNB_O) + (4 * q4) * OSTR + 32 * wave + r16;
        LDS_BARRIER();
#pragma unroll 1
        for (int c = c0; c < c1; ++c) {
            const LAS unsigned char* bb = lds + (c & 1) * DNB_BYTES;
            const float egl = ((const float*)(a.ws + DI_EGL))[bh * 32 + c];
            bf16x8v sb[2][4];
#pragma unroll
            for (int ct = 0; ct < 2; ++ct)
#pragma unroll
                for (int kk = 0; kk < 4; ++kk) sb[ct][kk] = pack8(S[ct][2 * kk], S[ct][2 * kk + 1]);
#define DN_SB() __builtin_amdgcn_sched_barrier(0)
            f32x4 vn[2][4];
#pragma unroll
            for (int hf = 0; hf < 2; ++hf) {
                bf16x8v fw[2][4]; float uv[2][8];
#pragma unroll
                for (int i = 0; i < 2; ++i) {
#pragma unroll
                    for (int kk = 0; kk < 4; ++kk) fw[i][kk] = *(const LAS bf16x8v*)(bb + DNB_W + (2 * hf + i) * 4096 + fA[kk]);
#pragma unroll
                    for (int ct = 0; ct < 2; ++ct)
#pragma unroll
                        for (int r = 0; r < 4; ++r) uv[ct][4 * i + r] = bf2f(*(const LAS bf16*)(lds + DNB_U + (2 * hf + i) * 4096 + r * 256 + uoff[ct][r])); }
#pragma unroll
                for (int ct = 0; ct < 2; ++ct) { vn[ct][2 * hf] = (f32x4){0.f, 0.f, 0.f, 0.f}; vn[ct][2 * hf + 1] = (f32x4){0.f, 0.f, 0.f, 0.f}; }
                DN_SB();
#pragma unroll
                for (int kk = 0; kk < 4; ++kk)
#pragma unroll
                    for (int i = 0; i < 2; ++i)
#pragma unroll
                        for (int ct = 0; ct < 2; ++ct) vn[ct][2 * hf + i] = __builtin_amdgcn_mfma_f32_16x16x32_bf16(fw[i][kk], sb[ct][kk], vn[ct][2 * hf + i], 0, 0, 0);
                DN_SB();
#pragma unroll
                for (int ct = 0; ct < 2; ++ct)
#pragma unroll
                    for (int i = 0; i < 2; ++i)
#pragma unroll
                        for (int r = 0; r < 4; ++r) vn[ct][2 * hf + i][r] = uv[ct][4 * i + r] - vn[ct][2 * hf + i][r];
            }
            bf16x8v vb[2][2];
#pragma unroll
            for (int ct = 0; ct < 2; ++ct) { vb[ct][0] = pack8(vn[ct][0], vn[ct][1]); vb[ct][1] = pack8(vn[ct][2], vn[ct][3]); }
            LDS_BARRIER();
#pragma unroll
            for (int hf = 0; hf < 2; ++hf) {
                f32x4 o[2][2];
                bf16x8v fq[2][4], fa[2][2];
#pragma unroll
                for (int i = 0; i < 2; ++i) {
#pragma unroll
                    for (int kk = 0; kk < 4; ++kk) fq[i][kk] = *(const LAS bf16x8v*)(bb + DNB_QG + (2 * hf + i) * 4096 + fA[kk]);
#pragma unroll
                    for (int k2 = 0; k2 < 2; ++k2) fa[i][k2] = *(const LAS bf16x8v*)(bb + DNB_ATT + (2 * hf + i) * 2048 + fB[k2]); }
#pragma unroll
                for (int ct = 0; ct < 2; ++ct) { o[ct][0] = (f32x4){0.f, 0.f, 0.f, 0.f}; o[ct][1] = (f32x4){0.f, 0.f, 0.f, 0.f}; }
                DN_SB();
#pragma unroll
                for (int kk = 0; kk < 4; ++kk)
#pragma unroll
                    for (int i = 0; i < 2; ++i)
#pragma unroll
                        for (int ct = 0; ct < 2; ++ct) o[ct][i] = __builtin_amdgcn_mfma_f32_16x16x32_bf16(fq[i][kk], sb[ct][kk], o[ct][i], 0, 0, 0);
#pragma unroll
                for (int k2 = 0; k2 < 2; ++k2)
#pragma unroll
                    for (int i = 0; i < 2; ++i)
#pragma unroll
                        for (int ct = 0; ct < 2; ++ct) o[ct][i] = __builtin_amdgcn_mfma_f32_16x16x32_bf16(fa[i][k2], vb[ct][k2], o[ct][i], 0, 0, 0);
                DN_SB();
#pragma unroll
                for (int ct = 0; ct < 2; ++ct)
#pragma unroll
                    for (int i = 0; i < 2; ++i)
#pragma unroll
                        for (int r = 0; r < 4; ++r) obase[(16 * (2 * hf + i) + r) * OSTR + 16 * ct] = (bf16)f2bf(o[ct][i][r]);
            }
#pragma unroll
            for (int ct = 0; ct < 2; ++ct)
#pragma unroll
                for (int j = 0; j < 8; ++j) S[ct][j] = S[ct][j] * egl;
#pragma unroll
            for (int hf = 0; hf < 2; ++hf) {
                bf16x8v fk[4][2];
#pragma unroll
                for (int j = 0; j < 4; ++j)
#pragma unroll
                    for (int k2 = 0; k2 < 2; ++k2) fk[j][k2] = *(const LAS bf16x8v*)(bb + DNB_KGT + (4 * hf + j) * 2048 + fB[k2]);
                DN_SB();
#pragma unroll
                for (int k2 = 0; k2 < 2; ++k2)
#pragma unroll
                    for (int j = 0; j < 4; ++j)
#pragma unroll
                        for (int ct = 0; ct < 2; ++ct) S[ct][4 * hf + j] = __builtin_amdgcn_mfma_f32_16x16x32_bf16(fk[j][k2], vb[ct][k2], S[ct][4 * hf + j], 0, 0, 0);
                DN_SB();
            }
#undef DN_SB
            LDS_BARRIER();
        }
        if (c1 < 32) {
#pragma unroll
            for (int ct = 0; ct < 2; ++ct)
#pragma unroll
                for (int j = 0; j < 8; ++j) sst[256 * (8 * ct + j)] = S[ct][j];
        } else {
            float* So = a.out + OFF_DP + (((size_t)(l * NB + b) * DNH + h) << 14) + 32 * wave + r16;
#pragma unroll
            for (int ct = 0; ct < 2; ++ct)
#pragma unroll
                for (int j = 0; j < 8; ++j)
#pragma unroll
                    for (int r = 0; r < 4; ++r) So[(16 * j + 4 * q4 + r) * 128 + 16 * ct] = S[ct][j][r];
        }
        LDS_BARRIER();
    } else {
        const int et = tid - 256;
        int offA[4], offB[4];
#pragma unroll
        for (int n = 0; n < 4; ++n) { const int p = et + 256 * n; offA[n] = (p >> 4) * 256 + (((p & 15) ^ ((p >> 4) & 15)) << 4); offB[n] = (p >> 3) * 128 + (((p & 7) ^ ((p >> 4) & 7)) << 4); }
        v4u pw[4], pq[4], pk[4], pa[2], pu[4];
#define DN_ISSUE(cn) do { const size_t it_ = (size_t)(bh * 32 + (cn)); \
        const v4u* gw = (const v4u*)((const bf16*)(a.ws + DI_W) + it_ * 8192) + et; const v4u* gq = (const v4u*)((const bf16*)(a.ws + DI_QG) + it_ * 8192) + et; \
        const v4u* gk = (const v4u*)((const bf16*)(a.ws + DI_KGT) + it_ * 8192) + et; const v4u* ga = (const v4u*)((const bf16*)(a.ws + DI_ATT) + it_ * 4096) + et; \
        const v4u* gu = (const v4u*)((const bf16*)(a.ws + DI_U) + it_ * 8192) + et; \
        _Pragma("unroll") for (int n_ = 0; n_ < 4; ++n_) { pw[n_] = gw[256 * n_]; pq[n_] = gq[256 * n_]; pk[n_] = gk[256 * n_]; pu[n_] = gu[256 * n_]; } \
        pa[0] = ga[0]; pa[1] = ga[256]; } while (0)
#define DN_COMMIT_OPS(cn) do { LAS unsigned char* bb_ = lds + ((cn) & 1) * DNB_BYTES; \
        _Pragma("unroll") for (int n_ = 0; n_ < 4; ++n_) { *(LAS v4u*)(bb_ + DNB_W + offA[n_]) = pw[n_]; *(LAS v4u*)(bb_ + DNB_QG + offA[n_]) = pq[n_]; *(LAS v4u*)(bb_ + DNB_KGT + offB[n_]) = pk[n_]; } \
        *(LAS v4u*)(bb_ + DNB_ATT + offB[0]) = pa[0]; *(LAS v4u*)(bb_ + DNB_ATT + offB[1]) = pa[1]; } while (0)
#define DN_COMMIT_U() do { _Pragma("unroll") for (int n_ = 0; n_ < 4; ++n_) *(LAS v4u*)(lds + DNB_U + offA[n_]) = pu[n_]; } while (0)
        const int ew = wave - 4, trow = 16 * ew + (lane >> 2), cg = lane & 3;
        v4u zc[4];
#define DN_ZLOAD(cz) do { const v4u* zp = (const v4u*)(PROJ + (size_t)(b * SEQ + 64 * (cz) + trow) * NPROJ + 2560 + h * 128 + 32 * cg); \
        _Pragma("unroll") for (int k_ = 0; k_ < 4; ++k_) zc[k_] = zp[k_]; } while (0)
        DN_ISSUE(c0);
        DN_COMMIT_OPS(c0); DN_COMMIT_U();
        if (c0 + 1 < c1) DN_ISSUE(c0 + 1);
        DN_ZLOAD(c0);
        LDS_BARRIER();
#define DN_EPI_READ() v4u ov[4]; { const LAS v4u* op = (const LAS v4u*)((LAS bf16*)(lds + DNB_O) + trow * OSTR + 32 * cg); _Pragma("unroll") for (int k_ = 0; k_ < 4; ++k_) ov[k_] = op[k_]; }
#define DN_EPI_FINISH(cp) do { float ss_ = 0.f; \
        _Pragma("unroll") for (int k_ = 0; k_ < 4; ++k_) { const unsigned w4_[4] = {ov[k_].x, ov[k_].y, ov[k_].z, ov[k_].w}; \
            _Pragma("unroll") for (int e_ = 0; e_ < 4; ++e_) { const float o0_ = __builtin_bit_cast(float, w4_[e_] << 16), o1_ = __builtin_bit_cast(float, w4_[e_] & 0xffff0000u); ss_ += o0_ * o0_ + o1_ * o1_; } } \
        ss_ = DPP_ADD(ss_, 0xB1); ss_ = DPP_ADD(ss_, 0x4E); \
        const float rstd_ = __builtin_amdgcn_rsqf(ss_ * (1.0f / DHD) + EPS); \
        v4u* mp_ = (v4u*)(MIX + (size_t)(b * SEQ + 64 * (cp) + trow) * DM + 512 + h * 128 + 32 * cg); \
        const f32x4* nwp_ = (const f32x4*)(a.in[I_DNNW] + l * DHD + 32 * cg); \
        _Pragma("unroll") for (int k_ = 0; k_ < 4; ++k_) { const unsigned w4_[4] = {ov[k_].x, ov[k_].y, ov[k_].z, ov[k_].w}; const unsigned z4_[4] = {zc[k_].x, zc[k_].y, zc[k_].z, zc[k_].w}; unsigned r4_[4]; \
            const f32x4 nwa_ = nwp_[2 * k_], nwb_ = nwp_[2 * k_ + 1]; const float nw8_[8] = {nwa_.x, nwa_.y, nwa_.z, nwa_.w, nwb_.x, nwb_.y, nwb_.z, nwb_.w}; \
            _Pragma("unroll") for (int e_ = 0; e_ < 4; ++e_) { const float z0_ = __builtin_bit_cast(float, z4_[e_] << 16), z1_ = __builtin_bit_cast(float, z4_[e_] & 0xffff0000u); \
                const float o0_ = __builtin_bit_cast(float, w4_[e_] << 16), o1_ = __builtin_bit_cast(float, w4_[e_] & 0xffff0000u); \
                r4_[e_] = cvtpk_s(o0_ * rstd_ * nw8_[2 * e_] * silu_fast(z0_), o1_ * rstd_ * nw8_[2 * e_ + 1] * silu_fast(z1_)); } \
            mp_[k_] = (v4u){r4_[0], r4_[1], r4_[2], r4_[3]}; } } while (0)
#pragma unroll 1
        for (int c = c0; c < c1; ++c) {
            if (c > c0) { DN_EPI_READ();
                if (c + 1 < c1) DN_COMMIT_OPS(c + 1);
                LDS_BARRIER();
                if (c + 1 < c1) DN_COMMIT_U();
                DN_EPI_FINISH(c - 1);
                DN_ZLOAD(c);
                if (c + 2 < c1) DN_ISSUE(c + 2);
            } else {
                if (c + 1 < c1) DN_COMMIT_OPS(c + 1);
                LDS_BARRIER();
                if (c + 1 < c1) DN_COMMIT_U();
                if (c + 2 < c1) DN_ISSUE(c + 2);
            }
            LDS_BARRIER();
        }
        { DN_EPI_READ(); DN_EPI_FINISH(c1 - 1); }
        LDS_BARRIER();
#undef DN_ISSUE
#undef DN_COMMIT_OPS
#undef DN_COMMIT_U
#undef DN_ZLOAD
#undef DN_EPI_READ
#undef DN_EPI_FINISH
    }
}


constexpr size_t RG_SUMS = WS_XN + 9 * MiB;
constexpr size_t RG_AV = 353 * MiB, RG_BV = RG_AV + 32 * MiB;
constexpr int XSTR = 68;
constexpr int XBSTR = 72;
constexpr int PSTR = 64;
constexpr int RG_RAW = 0, RG_XS = 68608, RG_PA = RG_XS + 64 * XSTR * 4, RG_PX = RG_PA + 64 * PSTR * 4, RG_XB = RG_PX + 64 * PSTR * 4, RG_PP = RG_XB + 64 * XBSTR * 2, RG_HH = RG_PP + 2048, RG_HIN = RG_HH + 2048, RG_END = RG_HIN + 2048;
static_assert(RG_END <= LDSCTL_OFF, "RG tile LDS map");
template <bool FIN>
__device__ __forceinline__ void rg_tile(const Args& a, int l, int tile, LAS unsigned char* lds, int tid) {
    asm volatile("" : "+v"(tid));
    LAS bf16* raw = (LAS bf16*)(lds + RG_RAW);
    LAS float* xs = (LAS float*)(lds + RG_XS);
    LAS float* pa = (LAS float*)(lds + RG_PA);
    LAS float* px = (LAS float*)(lds + RG_PX);
    LAS bf16* xb = (LAS bf16*)(lds + RG_XB);
    LAS float* PP = (LAS float*)(lds + RG_PP);
    LAS float* HH = (LAS float*)(lds + RG_HH);
    LAS float* hin = (LAS float*)(lds + RG_HIN);
    const int lane = tid & 63, wave = __builtin_amdgcn_readfirstlane(tid >> 6), q4 = lane >> 4, r16 = lane & 15;
    const bool prompt = tile < NB * 32;
    const int b = tile >> 5, c = tile & 31, gsm = tile - NB * 32;
    const int mbase = prompt ? b * SEQ + 64 * c : MP + 64 * gsm;
    const bf16* PROJ = (const bf16*)(a.ws + WS_H);
    float* SUMS = (float*)(a.ws + RG_SUMS);
    const bool light = FIN && prompt;
    if (!light)
#pragma unroll
    for (int n = 0; n < 9; ++n) { const int p = tid + 512 * n; if (p < 67 * 64) { const int slot = p >> 6, pc = p & 63, m = mbase - 3 + slot;
        v4u v = (v4u){0u, 0u, 0u, 0u};
        if (slot >= 3 || (prompt && c > 0)) v = *(const v4u*)(PROJ + (size_t)m * NPROJ + 8 * pc);
        *(LAS v4u*)(raw + slot * 512 + 8 * pc) = v; } }
    if (FIN && prompt) {
        float Pv[31], Hv[31];
#pragma unroll
        for (int cc = 0; cc < 31; ++cc) { Pv[cc] = 1.f; Hv[cc] = 0.f; if (cc < c) { const float* sp = SUMS + (size_t)(b * 32 + cc) * 1024; Pv[cc] = sp[tid]; Hv[cc] = sp[512 + tid]; } }
        float hh = 0.f;
#pragma unroll
        for (int cc = 0; cc < 31; ++cc) hh = Pv[cc] * hh + Hv[cc];
        hin[tid] = hh;
    }
    LDS_BARRIER();
#pragma unroll 1
    for (int hd = 0; hd < 8; ++hd) {
        const int ch = hd * 64 + lane;
        float av[8], bv[8], P = 1.f, Hl = 0.f;
        float gv[8];
        if (FIN) {
#pragma unroll
            for (int t = 0; t < 8; ++t) gv[t] = bf2f(PROJ[(size_t)(mbase + 8 * wave + t) * NPROJ + 2048 + ch]);
        }
        if (light) {
            const float* ap = (const float*)(a.ws + RG_AV) + (size_t)(mbase + 8 * wave) * RGW + ch; const float* bp = (const float*)(a.ws + RG_BV) + (size_t)(mbase + 8 * wave) * RGW + ch;
#pragma unroll
            for (int t = 0; t < 8; ++t) { av[t] = ap[t * RGW]; bv[t] = bp[t * RGW]; }
#pragma unroll
            for (int t = 0; t < 8; ++t) { P *= av[t]; Hl = av[t] * Hl + bv[t]; }
        } else {
        const float* wm = a.in[(wave >> 2) ? I_RGWX : I_RGWA] + ((size_t)(l * 8 + hd) * 64) * 64 + 16 * (wave & 3) + r16;
        float bwf[16];
#pragma unroll
        for (int kk = 0; kk < 2; ++kk)
#pragma unroll
            for (int jj = 0; jj < 8; ++jj) bwf[8 * kk + jj] = wm[(32 * kk + 8 * q4 + jj) * 64];
        const float ba = a.in[I_RGBA][l * RGW + ch], bx = a.in[I_RGBX][l * RGW + ch], lam = a.in[I_LAM][l * RGW + ch];
        {
            const int i = tid >> 3, sub = tid & 7, chb = hd * 64 + 8 * sub;
            const int t = prompt ? 3 : (i & 7);
            float o[8];
            const f32x4* bp = (const f32x4*)(a.in[I_CONVB] + l * RGW + chb);
            { const f32x4 b0 = bp[0], b1 = bp[1]; o[0] = b0.x; o[1] = b0.y; o[2] = b0.z; o[3] = b0.w; o[4] = b1.x; o[5] = b1.y; o[6] = b1.z; o[7] = b1.w; }
#pragma unroll
            for (int tap = 0; tap < 4; ++tap) {
                const int back = 3 - tap;
                const f32x4* wp = (const f32x4*)(a.in[I_CONVW] + ((size_t)l * 4 + tap) * CONVCH + chb);
                const f32x4 w0 = wp[0], w1 = wp[1];
                float xv[8];
                if (t - back >= 0) { const v4u x0 = *(const LAS v4u*)(raw + (3 + i - back) * 512 + chb);
                    xv[0] = __builtin_bit_cast(float, x0.x << 16); xv[1] = __builtin_bit_cast(float, x0.x & 0xffff0000u); xv[2] = __builtin_bit_cast(float, x0.y << 16); xv[3] = __builtin_bit_cast(float, x0.y & 0xffff0000u);
                    xv[4] = __builtin_bit_cast(float, x0.z << 16); xv[5] = __builtin_bit_cast(float, x0.z & 0xffff0000u); xv[6] = __builtin_bit_cast(float, x0.w << 16); xv[7] = __builtin_bit_cast(float, x0.w & 0xffff0000u); }
                else { const f32x4* sp = (const f32x4*)(a.in[I_SCONV] + ((size_t)(l * NDB + 8 * gsm + (i >> 3)) * 3 + (3 + t - back)) * CONVCH + chb);
                    const f32x4 s0 = sp[0], s1 = sp[1]; xv[0] = s0.x; xv[1] = s0.y; xv[2] = s0.z; xv[3] = s0.w; xv[4] = s1.x; xv[5] = s1.y; xv[6] = s1.z; xv[7] = s1.w; }
                o[0] += w0.x * xv[0]; o[1] += w0.y * xv[1]; o[2] += w0.z * xv[2]; o[3] += w0.w * xv[3];
                o[4] += w1.x * xv[4]; o[5] += w1.y * xv[5]; o[6] += w1.z * xv[6]; o[7] += w1.w * xv[7];
            }
            LAS float* dst = xs + i * XSTR + 8 * sub;
            *(LAS f32x4*)dst = (f32x4){o[0], o[1], o[2], o[3]}; *(LAS f32x4*)(dst + 4) = (f32x4){o[4], o[5], o[6], o[7]};
            v4u ob; ob.x = cvtpk_s(o[0], o[1]); ob.y = cvtpk_s(o[2], o[3]); ob.z = cvtpk_s(o[4], o[5]); ob.w = cvtpk_s(o[6], o[7]);
            *(LAS v4u*)(xb + i * XBSTR + 8 * sub) = ob;
        }
        LDS_BARRIER();
        {
            bf16x8v bw[2];
            bw[0] = pack8((f32x4){bwf[0], bwf[1], bwf[2], bwf[3]}, (f32x4){bwf[4], bwf[5], bwf[6], bwf[7]});
            bw[1] = pack8((f32x4){bwf[8], bwf[9], bwf[10], bwf[11]}, (f32x4){bwf[12], bwf[13], bwf[14], bwf[15]});
            LAS float* outp = ((wave >> 2) ? px : pa) + 16 * (wave & 3) + r16;
            bf16x8v af[4][2];
#pragma unroll
            for (int ti = 0; ti < 4; ++ti)
#pragma unroll
                for (int kk = 0; kk < 2; ++kk) af[ti][kk] = *(const LAS bf16x8v*)(xb + (16 * ti + r16) * XBSTR + 32 * kk + 8 * q4);
#pragma unroll
            for (int ti = 0; ti < 4; ++ti) {
                f32x4 acc = (f32x4){0.f, 0.f, 0.f, 0.f};
                acc = __builtin_amdgcn_mfma_f32_16x16x32_bf16(af[ti][0], bw[0], acc, 0, 0, 0);
                acc = __builtin_amdgcn_mfma_f32_16x16x32_bf16(af[ti][1], bw[1], acc, 0, 0, 0);
#pragma unroll
                for (int r = 0; r < 4; ++r) outp[(16 * ti + 4 * q4 + r) * PSTR] = acc[r];
            }
        }
        LDS_BARRIER();
        const float spl = softplus_f(-lam);
#pragma unroll
        for (int t = 0; t < 8; ++t) { const int i = 8 * wave + t;
            const float r = sigmoid_f(pa[i * PSTR + lane] + ba), ig = sigmoid_f(px[i * PSTR + lane] + bx), la = -8.0f * r * spl;
            av[t] = __builtin_amdgcn_exp2f(1.44269504089f * la); bv[t] = __builtin_amdgcn_sqrtf(neg_expm1_f(2.0f * la)) * (ig * xs[i * XSTR + lane]);
            P *= av[t]; Hl = av[t] * Hl + bv[t]; }
        if (!FIN) {
            float* ap = (float*)(a.ws + RG_AV) + (size_t)(mbase + 8 * wave) * RGW + ch; float* bp = (float*)(a.ws + RG_BV) + (size_t)(mbase + 8 * wave) * RGW + ch;
#pragma unroll
            for (int t = 0; t < 8; ++t) { ap[t * RGW] = av[t]; bp[t * RGW] = bv[t]; }
        }
        }
        float hh;
        if (prompt) {
            PP[wave * 64 + lane] = P; HH[wave * 64 + lane] = Hl;
            LDS_BARRIER();
            hh = FIN ? hin[ch] : 0.f;
            for (int g = 0; g < wave; ++g) hh = PP[g * 64 + lane] * hh + HH[g * 64 + lane];
            if (!FIN && wave == 7) {
                float pt = P;
#pragma unroll
                for (int g = 0; g < 7; ++g) pt *= PP[g * 64 + lane];
                float* sp = SUMS + (size_t)tile * 1024; sp[ch] = pt; sp[512 + ch] = P * hh + Hl;
            }
        } else hh = a.in[I_SRG][(size_t)(l * NDB + 8 * gsm + wave) * RGW + ch];
        if (FIN) {
            bf16* MIX = (bf16*)(a.ws + WS_MIX);
#pragma unroll
            for (int t = 0; t < 8; ++t) { const size_t m = (size_t)(mbase + 8 * wave + t);
                hh = av[t] * hh + bv[t];
                MIX[m * DM + ch] = (bf16)f2bf(hh * gelu_tanh_f(gv[t])); }
            if (prompt) { if (c == 31 && wave == 7) a.out[OFF_RP + (size_t)(l * NB + b) * RGW + ch] = hh; }
            else a.out[OFF_RS + (size_t)(l * NDB + 8 * gsm + wave) * RGW + ch] = hh;
        }
        LDS_BARRIER();
    }
}


constexpr int NSCAN = NB * DNH;
__device__ __forceinline__ void prepa_phase(const Args& a, int l, LAS unsigned char* lds, int tid0) {
    { int tid = tid0; asm volatile("" : "+v"(tid));
      for (int rp = 0; rp < PROBE_PDN; ++rp) for (int j = blockIdx.x; j < NSCAN * 16; j += gridDim.x) dnprep_item(a, l, (j >> 4) * 32 + (j & 15), lds, tid); }
    int tid = tid0; asm volatile("" : "+v"(tid));
    const bf16* PROJ = (const bf16*)(a.ws + WS_H);
    for (int idx = blockIdx.x * (NWAVES * 64) + tid; idx < (NB + NDB) * 3 * CONVCH; idx += gridDim.x * NWAVES * 64) {
        const int c = idx & (CONVCH - 1), jr = (idx >> 11) % 3, sq = idx / (3 * CONVCH);
        if (sq < NB) a.out[OFF_CP + ((size_t)(l * NB + sq) * 3 + jr) * CONVCH + c] = bf2f(PROJ[(size_t)(sq * SEQ + SEQ - 3 + jr) * NPROJ + c]);
        else { const int bs = sq - NB; a.out[OFF_CS + ((size_t)(l * NDB + bs) * 3 + jr) * CONVCH + c] = bf2f(PROJ[(size_t)(MP + bs * DSEQ + DSEQ - 3 + jr) * NPROJ + c]); }
    }
}
constexpr int CW_QUEUE = 2048;
__device__ __forceinline__ int queue_next(gu32* ctr, volatile LAS unsigned* slot, int tid) {
    if (tid == 0) *slot = __hip_atomic_fetch_add(ctr, 1u, RLX_AGENT);
    LDS_BARRIER();
    const int it = (int)*slot;
    LDS_BARRIER();
    return it;
}
__device__ __forceinline__ void mid_phase(const Args& a, int l, LAS unsigned char* lds, volatile LAS unsigned* MISC, int tid0) {
    if ((int)blockIdx.x < NSCAN || (int)gridDim.x <= NSCAN) {
        int tid = tid0; asm volatile("" : "+v"(tid));
        for (int rp = 0; rp < PROBE_SFA; ++rp) for (int it = blockIdx.x; it < NSCAN; it += gridDim.x) dnscan_wg(a, l, it, 0, 16, lds, tid);
    }
    gu32* ctr = (gu32*)(a.ws + WS_CTL) + CW_QUEUE + 64 * (2 * l);
    constexpr int NRG = NB * 32, NDN = NSCAN * 16;
    for (;;) {
        int tid = tid0; asm volatile("" : "+v"(tid));
        const int it = queue_next(ctr, MISC + 16, tid);
        if (it >= NRG + NDN) break;
        if (it < NRG) rg_tile<false>(a, l, it, lds, tid);
        else { const int j = it - NRG; dnprep_item(a, l, (j >> 4) * 32 + 16 + (j & 15), lds, tid); }
    }
}
__device__ __forceinline__ void fin_phase(const Args& a, int l, LAS unsigned char* lds, volatile LAS unsigned* MISC, int tid0) {
    if ((int)blockIdx.x < NSCAN || (int)gridDim.x <= NSCAN) {
        int tid = tid0; asm volatile("" : "+v"(tid));
        for (int rp = 0; rp < PROBE_SFA; ++rp) for (int it = blockIdx.x; it < NSCAN; it += gridDim.x) dnscan_wg(a, l, it, 16, 32, lds, tid);
    }
    gu32* ctr = (gu32*)(a.ws + WS_CTL) + CW_QUEUE + 64 * (2 * l + 1);
    constexpr int NRG = NB * 32 + NDB / 8, NDL = 2 * NDB;
    for (;;) {
        int tid = tid0; asm volatile("" : "+v"(tid));
        const int it = queue_next(ctr, MISC + 16, tid);
        if (it >= NRG + NDL) break;
        if (it < NRG) rg_tile<true>(a, l, it, lds, tid);
        else delta_seq(a, l, it - NRG, lds, tid);
    }
}

constexpr int PH_PER_LAYER = 13, N_PHASES = DEPTH * PH_PER_LAYER;
enum { Q_WCVT = 0, Q_UP1, Q_DN1, Q_NORM1, Q_WIN, Q_PREPA, Q_MID, Q_FIN, Q_WOUT, Q_NORM2, Q_UP2, Q_DN2, Q_NORM3 };
__global__ void __launch_bounds__(NWAVES * 64, 2) fwd_kernel(Args a0) {
    extern __shared__ __attribute__((aligned(16))) unsigned char lds_raw[];
    LAS unsigned char* lds = (LAS unsigned char*)lds_raw;
    volatile LAS unsigned* MISC = (volatile LAS unsigned*)(lds + MISC_OFF);
    const int tid0 = threadIdx.x;
    for (int u = tid0; u < (LDS_BYTES - LDSCTL_OFF) / 4; u += NWAVES * 64) ((LAS unsigned*)(lds + LDSCTL_OFF))[u] = 0u;
    __syncthreads();
    const int lo = a0.ph_lo, hi = a0.ph_hi;
    gu32* ctl = (gu32*)(a0.ws + WS_CTL);
    typedef const __attribute__((address_space(4))) Args* CArgsP;
    CArgsP ap = (CArgsP)__builtin_amdgcn_kernarg_segment_ptr();
    XcdBarrier bar; bar.bar = (unsigned*)(ctl + CW_BAR); bar.x = 0; bar.st = nullptr;
    if (hi - lo > 1) bar = xcd_barrier_post((unsigned*)(ctl + CW_BAR), MISC + 8);
    const int hie = hi + (PROBE_Q >= 0 ? PROBE_REPS - 1 : 0);
    for (int st = lo; st < hie; ++st) {
        const int pi = (PROBE_Q >= 0 && st > PROBE_Q) ? (st - PROBE_Q < PROBE_REPS ? PROBE_Q : st - (PROBE_REPS - 1)) : st;
        asm volatile("" : "+s"(ap));
        const Args& a = *(const Args*)ap;
        int tid = tid0; asm volatile("" : "+v"(tid));
        const int lane = tid & 63, wave = __builtin_amdgcn_readfirstlane(tid >> 6);
        const int l = pi / PH_PER_LAYER, q = pi - l * PH_PER_LAYER;
        if (l == 1 && q == Q_WCVT && lo < pi) continue;

        if (q == Q_UP1 || q == Q_DN1 || q == Q_WIN || q == Q_WOUT || q == Q_UP2 || q == Q_DN2) {
#if EN_GEMM
            const bool isup = (q == Q_UP1 || q == Q_UP2), isdn = (q == Q_DN1 || q == Q_DN2);
            const bf16* A = (isup || q == Q_WIN) ? (const bf16*)(a.ws + WS_XN) : (isdn ? (const bf16*)(a.ws + WS_H) : (const bf16*)(a.ws + WS_MIX));
            const size_t wo = q == Q_UP1 ? WO_UP1 : q == Q_DN1 ? WO_DN1 : q == Q_WIN ? WO_WIN : q == Q_WOUT ? WO_WOUT : q == Q_UP2 ? WO_UP2 : WO_DN2;
            const int N = isup ? 2 * DFF : (q == Q_WIN ? NPROJ : DM), K = isdn ? DFF : DM;
            pg8::Gemm g{A, (const bf16*)(a.ws + WS_W + wo), M, N, K};
            const bool isd = !(isup || q == Q_WIN);
            const int nsp = isd ? (isdn ? NSPLIT_DN : NSPLIT_OUT) : 1;
            pg8::SplitOrder S; S.init(isd ? MP : M, isd ? MS : 0, N, K, nsp, gridDim.x, (int)blockIdx.x);
            pg8::EpiAny E{isup ? 0 : 1, isd ? (bf16*)(a.ws + WS_D) : (bf16*)(a.ws + WS_H), isup ? DFF : (isd ? DM : NPROJ), isd ? MP / 256 : M / 256, (bf16*)(a.ws + WS_DSLAB)};
            pg8::gemm_phase<pg8::EpiAny, pg8::SplitOrder, true, true>(lds, g, S, E);
#if EN_WCVT
            {
                const int nun = isd ? (MP / 256) * (N / 256) + (MS / 256) * (N / 256) * nsp : (M / 256) * (N / 256);
                const int nrem = nun % (int)gridDim.x, nidle = nrem ? (int)gridDim.x - nrem : (int)gridDim.x, me = nrem ? (int)blockIdx.x - nrem : (int)blockIdx.x;
                int lo_ = 0, hi_ = 0, lw = l;
                if (l == 0 && q == Q_WIN) { lo_ = WI_0; hi_ = WI_1; lw = 1; } else if (l == 0 && q == Q_UP2) { lo_ = WI_1; hi_ = WI_2; lw = 1; } else if (l == 1 && q == Q_WIN) { lo_ = WI_2; hi_ = WI_3; }
                if (hi_ > lo_ && me >= 0) wcvt_range(a, lw, lo_, hi_, me * NWAVES + wave, nidle * NWAVES, lds, wave, lane);
                __syncthreads();
            }
#endif
#endif
#if EN_SCAL
            if (q == Q_WIN) for (int rs = 0; rs < PROBE_SCAL; ++rs) scal_phase(a, l, lds, tid, wave, lane);
#endif
        } else if (q == Q_WCVT) {
#if EN_WCVT
            if (l == 0) { wcvt_range(a, 0, WI_0, WI_3, blockIdx.x * NWAVES + wave, gridDim.x * NWAVES, lds, wave, lane); xn0_phase(a, wave, lane); }
#endif
        } else if (q == Q_PREPA) {
#if EN_PREP
            prepa_phase(a, l, lds, tid);
#endif
        } else if (q == Q_MID) {
#if EN_PREP
            mid_phase(a, l, lds, MISC, tid);
#endif
        } else if (q == Q_FIN) {
#if EN_SCANFIN
            fin_phase(a, l, lds, MISC, tid);
#endif
        } else {
#if EN_NORM
            const int s = q == Q_NORM1 ? 0 : (q == Q_NORM2 ? 1 : 2);
            const float* gpost = a.in[s == 0 ? I_F1POST : (s == 1 ? I_MPOST : I_F2POST)] + l * DM;
            const float* gnext = s == 0 ? a.in[I_MPRE] + l * DM : (s == 1 ? a.in[I_F2PRE] + l * DM : (l + 1 < DEPTH ? a.in[I_F1PRE] + (l + 1) * DM : a.in[I_FINAL]));
            norm_phase(a, gpost, gnext, s == 1 ? 1.0f : 0.5f, 3 * l + s, pi == N_PHASES - 1, s == 1 ? NSPLIT_OUT : NSPLIT_DN, wave, lane);
#endif
        }
        if (st + 1 < hie) for (int pb = 0; pb < PROBE_BAR; ++pb) xcd_barrier(bar);
    }
}

extern "C" void kernel_launch(void* const* d_in, const int* in_sizes, int n_in, void* d_out, int out_size, void* d_ws, size_t ws_size, hipStream_t stream) {
    static int grid = 0;
    if (grid == 0) {
        if (n_in != N_IN || out_size != (int)OUT_TOTAL || ws_size < WS_END) { fprintf(stderr, "kernel_launch: unexpected shapes (n_in %d, out %d, ws %zu); nothing launched\n", n_in, out_size, ws_size); grid = -1; return; }
        int dev = 0, cus = 0;
        if (hipGetDevice(&dev) != hipSuccess || hipDeviceGetAttribute(&cus, hipDeviceAttributeMultiprocessorCount, dev) != hipSuccess) { grid = -1; return; }
        if (hipFuncSetAttribute((const void*)fwd_kernel, hipFuncAttributeMaxDynamicSharedMemorySize, LDS_BYTES) != hipSuccess) { fprintf(stderr, "kernel_launch: hipFuncSetAttribute failed\n"); grid = -1; return; }
        (void)hipGetLastError();
        grid = cus;
    }
    if (grid < 0) return;
    if (hipMemsetAsync((char*)d_ws + WS_CTL, 0, CTL_ZERO_BYTES, stream) != hipSuccess) return;
    Args a{};
    for (int i = 0; i < N_IN; ++i) a.in[i] = (const float*)d_in[i];
    a.out = (float*)d_out; a.ws = (unsigned char*)d_ws;
#if MK_SINGLE
    a.ph_lo = 0; a.ph_hi = N_PHASES;
    hipLaunchKernelGGL(fwd_kernel, dim3(grid), dim3(NWAVES * 64), LDS_BYTES, stream, a);
#else
    for (int p = 0; p < N_PHASES; ++p) { a.ph_lo = p; a.ph_hi = p + 1; hipLaunchKernelGGL(fwd_kernel, dim3(grid), dim3(NWAVES * 64), LDS_BYTES, stream, a); }
#endif
}
```

```cpp
#include <hip/hip_runtime.h>
#include <cstdio>
#include <cstdint>
namespace pg8 {
#define PG8_LAS __attribute__((address_space(3)))
typedef unsigned short bf16_t;
typedef short bf16x8 __attribute__((ext_vector_type(8)));
typedef float f32x4 __attribute__((ext_vector_type(4)));
typedef unsigned u32x4 __attribute__((ext_vector_type(4)));
constexpr int BM = 256, BK = 64, HALF = 128, HTB = HALF * BK * 2  , STAGE_BYTES = 8 * HTB, NXCD = 8, WGM = 8;

__host__ __device__ __forceinline__ int lds_byte(int r, int c) { const int st = (r >> 4) * 2 + (c >> 5), rr = r & 15, cc = c & 31, ob = rr * 64 + cc * 2; return st * 1024 + (ob ^ (((ob >> 9) & 1) << 5)); }
__host__ __device__ __forceinline__ void stage_rc(int b, int& R, int& C) { const int st = b / 1024, sb = b % 1024, swz = sb ^ (((sb >> 9) & 1) << 5); R = (st >> 1) * 16 + swz / 64; C = (st & 1) * 32 + (swz % 64) / 2; }
__host__ __device__ __forceinline__ int perm32(int rho) { const int n = rho >> 4, i = rho & 15; return 8 * (i >> 2) + 4 * n + (i & 3); }

struct Unit { int pm, pn, kt0, nt, ks; };
struct Gemm { const bf16_t* A; const bf16_t* Bt; int M, N, K; };

struct StaticOrder {
    int nM, nN, nwg, G, c, ntf;
    __host__ __device__ void init(int M, int N, int G_, int c_) { nM = M / BM; nN = N / BM; nwg = nM * nN; G = G_; c = c_; }
    __host__ __device__ __forceinline__ bool next(int i, Unit& u) const {
        const long L = (long)i * G + c; if (L >= nwg) return false;
        int wgid = (int)L; { const int q = nwg / NXCD, r = nwg % NXCD, xcd = wgid % NXCD, off = wgid / NXCD; wgid = (xcd < r ? xcd * (q + 1) : r * (q + 1) + (xcd - r) * q) + off; }
        const int nig = WGM * nN, gid = wgid / nig, fm = gid * WGM, gsz = (nM - fm) < WGM ? (nM - fm) : WGM;
        u.pm = fm + ((wgid % nig) % gsz); u.pn = (wgid % nig) / gsz; u.kt0 = 0; u.nt = ntf; u.ks = 0; return true;
    }
    __device__ __forceinline__ void a_ready(const Unit&) const {}
    __device__ __forceinline__ void done(const Unit&) const {}
};
struct SplitOrder {
    StaticOrder full; int mfull, mrest, nN, nsplit, nts, nfull;
    __host__ __device__ void init(int Mfull, int Mrest, int N, int K, int nsplit_, int G_, int c_) { full.init(Mfull, N, G_, c_); full.ntf = K / BK; mfull = Mfull / BM; mrest = Mrest / BM; nN = N / BM; nsplit = nsplit_; nts = K / BK / nsplit_; nfull = full.nwg; }
    __host__ __device__ __forceinline__ bool next(int i, Unit& u) const {
        const int L = i * full.G + full.c;
        const int j = L - nfull, nrest = mrest * nN * nsplit;
        if (j >= nrest) return false;
        Unit f; f.pm = 0; f.pn = 0; f.kt0 = 0; f.nt = 0; f.ks = 0;
        if (j < 0) (void)full.next(i, f);
        const int jj = j < 0 ? 0 : j, ks = jj % nsplit, q = jj / nsplit;
        const bool isfull = j < 0;
        u.pm = isfull ? f.pm : mfull + q / nN; u.pn = isfull ? f.pn : q % nN; u.ks = isfull ? 0 : ks; u.kt0 = isfull ? 0 : ks * nts; u.nt = isfull ? full.ntf : nts;
        return true;
    }
    __device__ __forceinline__ void a_ready(const Unit&) const {}
    __device__ __forceinline__ void done(const Unit&) const {}
};


__device__ __forceinline__ unsigned cvt_pk_bf16(float lo, float hi) { unsigned r; asm volatile("v_cvt_pk_bf16_f32 %0, %1, %2" : "=v"(r) : "v"(lo), "v"(hi)); return r; }
typedef float f32x2 __attribute__((ext_vector_type(2)));
struct EpiF32 {
    static constexpr bool PERM = false, AFTER_DRAIN = false;
    float* C; int ldc;
    __device__ __forceinline__ void operator()(const f32x4 (&acc)[2][2][4][2], const Unit& u, int wr, int wc, int fr, int fq) const {
        const int row0 = u.pm * BM + wr * 64 + fr, col0 = u.pn * BM + wc * 32 + 4 * fq;
#pragma unroll
        for (int ai = 0; ai < 2; ++ai)
#pragma unroll
            for (int m = 0; m < 4; ++m) { float* rowp = C + (size_t)(row0 + ai * HALF + m * 16) * ldc + col0;
#pragma unroll
                for (int bj = 0; bj < 2; ++bj)
#pragma unroll
                    for (int n = 0; n < 2; ++n) *(f32x4*)(rowp + bj * HALF + n * 16) = acc[ai][bj][m][n]; }
    }
};
struct EpiBf16 {
    static constexpr bool PERM = true, AFTER_DRAIN = false;
    bf16_t* O; int ldc;
    __device__ __forceinline__ void operator()(const f32x4 (&acc)[2][2][4][2], const Unit& u, int wr, int wc, int fr, int fq) const {
        const int row0 = u.pm * BM + wr * 64 + fr, col0 = u.pn * BM + wc * 32 + 8 * fq;
#pragma unroll
        for (int ai = 0; ai < 2; ++ai)
#pragma unroll
            for (int m = 0; m < 4; ++m) { bf16_t* rowp = O + (size_t)(row0 + ai * HALF + m * 16) * ldc + col0;
#pragma unroll
                for (int bj = 0; bj < 2; ++bj) { const f32x4 v0 = acc[ai][bj][m][0], v1 = acc[ai][bj][m][1];
                    u32x4 w; w.x = cvt_pk_bf16(v0[0], v0[1]); w.y = cvt_pk_bf16(v0[2], v0[3]); w.z = cvt_pk_bf16(v1[0], v1[1]); w.w = cvt_pk_bf16(v1[2], v1[3]);
                    *(u32x4*)(rowp + bj * HALF) = w; } }
    }
};
__device__ __forceinline__ float silu_f(float x) { return x * __builtin_amdgcn_rcpf(1.0f + __builtin_amdgcn_exp2f(-1.44269504089f * x)); }
struct EpiSwiGLU {
    static constexpr bool PERM = true, AFTER_DRAIN = false;
    bf16_t* O; int ldc;
    __device__ __forceinline__ void operator()(const f32x4 (&acc)[2][2][4][2], const Unit& u, int wr, int wc, int fr, int fq) const {
        const int row0 = u.pm * BM + wr * 64 + fr, col0 = u.pn * HALF + wc * 32 + 8 * fq;
#pragma unroll
        for (int ai = 0; ai < 2; ++ai)
#pragma unroll
            for (int m = 0; m < 4; ++m) { bf16_t* rowp = O + (size_t)(row0 + ai * HALF + m * 16) * ldc + col0;
                const f32x4 g0 = acc[ai][0][m][0], g1 = acc[ai][0][m][1], u0 = acc[ai][1][m][0], u1 = acc[ai][1][m][1];
                u32x4 w;
                w.x = cvt_pk_bf16(silu_f(g0[0]) * u0[0], silu_f(g0[1]) * u0[1]); w.y = cvt_pk_bf16(silu_f(g0[2]) * u0[2], silu_f(g0[3]) * u0[3]);
                w.z = cvt_pk_bf16(silu_f(g1[0]) * u1[0], silu_f(g1[1]) * u1[1]); w.w = cvt_pk_bf16(silu_f(g1[2]) * u1[2], silu_f(g1[3]) * u1[3]);
                *(u32x4*)rowp = w; }
    }
};

constexpr int M_ROWS = 17408;
struct EpiAny {
    static constexpr bool PERM = true, AFTER_DRAIN = false;
    int mode; bf16_t* O; int ldo; int mfull; bf16_t* Oslab;
    __device__ __forceinline__ void operator()(const f32x4 (&acc)[2][2][4][2], const Unit& u, int wr, int wc, int fr, int fq) const {
        const int row0 = u.pm * BM + wr * 64 + fr;
        if (mode == 0) {
            const int col0 = u.pn * HALF + wc * 32 + 8 * fq;
#pragma unroll
            for (int ai = 0; ai < 2; ++ai)
#pragma unroll
                for (int m = 0; m < 4; ++m) { bf16_t* rowp = O + (size_t)(row0 + ai * HALF + m * 16) * ldo + col0;
                    const f32x4 g0 = acc[ai][0][m][0], g1 = acc[ai][0][m][1], u0 = acc[ai][1][m][0], u1 = acc[ai][1][m][1];
                    u32x4 w;
                    w.x = cvt_pk_bf16(silu_f(g0[0]) * u0[0], silu_f(g0[1]) * u0[1]); w.y = cvt_pk_bf16(silu_f(g0[2]) * u0[2], silu_f(g0[3]) * u0[3]);
                    w.z = cvt_pk_bf16(silu_f(g1[0]) * u1[0], silu_f(g1[1]) * u1[1]); w.w = cvt_pk_bf16(silu_f(g1[2]) * u1[2], silu_f(g1[3]) * u1[3]);
                    *(u32x4*)rowp = w; }
        } else {
            const int col0 = u.pn * BM + wc * 32 + 8 * fq;
            bf16_t* Ob = u.pm < mfull ? O : Oslab + (size_t)u.ks * ((size_t)(M_ROWS - mfull * BM) * ldo) - (size_t)(mfull * BM) * ldo;
#pragma unroll
            for (int ai = 0; ai < 2; ++ai)
#pragma unroll
                for (int m = 0; m < 4; ++m) { bf16_t* rowp = Ob + (size_t)(row0 + ai * HALF + m * 16) * ldo + col0;
#pragma unroll
                    for (int bj = 0; bj < 2; ++bj) { const f32x4 v0 = acc[ai][bj][m][0], v1 = acc[ai][bj][m][1];
                        u32x4 w; w.x = cvt_pk_bf16(v0[0], v0[1]); w.y = cvt_pk_bf16(v0[2], v0[3]); w.z = cvt_pk_bf16(v1[0], v1[1]); w.w = cvt_pk_bf16(v1[2], v1[3]);
                        *(u32x4*)(rowp + bj * HALF) = w; } }
        }
    }
};
template <class Epi, class Sched, bool ALIGN_EPI = false, bool SP2 = false>
__device__ __forceinline__ void gemm_phase(PG8_LAS unsigned char* lds, const Gemm g, const Sched& S, const Epi& E) {
    int tid_l = threadIdx.x; asm volatile("" : "+v"(tid_l));
    const int tid = tid_l, wid = __builtin_amdgcn_readfirstlane(tid >> 6), lane = tid & 63, wr = wid >> 2, wc = wid & 3, fr = lane & 15, fq = lane >> 4;
    const int K = g.K;
    unsigned voffA[2], voffB[2];
#pragma unroll
    for (int i = 0; i < 2; ++i) { int R, C; stage_rc(tid * 16 + i * 8192, R, C); const int Rb = Epi::PERM ? ((R & ~31) + perm32(R & 31)) : R;
        voffA[i] = (unsigned)(R * K + C) * 2u; voffB[i] = (unsigned)(Rb * K + C) * 2u; }
    const size_t kstep = (size_t)(BK * 2);
    const size_t hstep = (size_t)HALF * K * 2;
    const size_t tstep = 2 * hstep;
    const unsigned ldsw = (unsigned)wid * 1024u;
    const int aoff = lds_byte(wr * 64 + fr, fq * 8), boff = lds_byte(wc * 32 + fr, fq * 8);
#define PG8_SA(b, h) (((b) * 2 + (h)) * HTB)
#define PG8_SB(b, h) ((4 + (b) * 2 + (h)) * HTB)
#define PG8_STAGE(bufoff, gbase, voff) do { _Pragma("unroll") for (int _i = 0; _i < 2; ++_i) \
        __builtin_amdgcn_global_load_lds((const unsigned*)((const char*)(gbase) + (voff)[_i]), (PG8_LAS unsigned*)(lds + (bufoff) + ldsw + _i * 8192), 16, 0, 0); } while (0)
#define PG8_LDA(dst, b, h) do { _Pragma("unroll") for (int m = 0; m < 4; ++m) _Pragma("unroll") for (int k = 0; k < 2; ++k) dst[m][k] = *(const PG8_LAS bf16x8*)(lds + PG8_SA(b, h) + aoff + m * 2048 + k * 1024); } while (0)
#define PG8_LDB(dst, b, h) do { _Pragma("unroll") for (int n = 0; n < 2; ++n) _Pragma("unroll") for (int k = 0; k < 2; ++k) dst[n][k] = *(const PG8_LAS bf16x8*)(lds + PG8_SB(b, h) + boff + n * 2048 + k * 1024); } while (0)
#define PG8_MMA(ai, bj, At, Bt) do { __builtin_amdgcn_s_setprio(1); _Pragma("unroll") for (int m = 0; m < 4; ++m) _Pragma("unroll") for (int n = 0; n < 2; ++n) _Pragma("unroll") for (int k = 0; k < 2; ++k) \
        acc[ai][bj][m][n] = __builtin_amdgcn_mfma_f32_16x16x32_bf16(Bt[n][k], At[m][k], acc[ai][bj][m][n], 0, 0, 0); __builtin_amdgcn_s_setprio(0); } while (0)
#define PG8_WAIT_V(n) asm volatile("s_waitcnt vmcnt(" #n ")" ::: "memory")
#define PG8_WAIT_L(n) asm volatile("s_waitcnt lgkmcnt(" #n ")" ::: "memory")
#define PG8_BAR __builtin_amdgcn_s_barrier()
#define PG8_SCHED __builtin_amdgcn_sched_barrier(0)
    Unit cur, nxt; int ui = 0;
    if (!S.next(0, cur)) return;
    f32x4 acc[2][2][4][2];
#pragma unroll
    for (int a = 0; a < 2; ++a)
#pragma unroll
        for (int b = 0; b < 2; ++b)
#pragma unroll
            for (int m = 0; m < 4; ++m)
#pragma unroll
                for (int n = 0; n < 2; ++n) acc[a][b][m][n] = (f32x4){0.f, 0.f, 0.f, 0.f};
    bf16x8 At[4][2], B0[2][2], B1[2][2];
    const char* cA = (const char*)g.A + (size_t)cur.pm * tstep + (size_t)cur.kt0 * (BK * 2); const char* cB = (const char*)g.Bt + (size_t)cur.pn * tstep + (size_t)cur.kt0 * (BK * 2);
    S.a_ready(cur);
    if constexpr (SP2) {
        PG8_STAGE(PG8_SB(0, 0), cB, voffB); PG8_STAGE(PG8_SB(0, 1), cB + hstep, voffB); PG8_STAGE(PG8_SA(0, 0), cA, voffA); PG8_STAGE(PG8_SA(0, 1), cA + hstep, voffA);
        if (wr == 1) PG8_BAR;
        PG8_WAIT_V(2); PG8_BAR;
        PG8_STAGE(PG8_SB(1, 0), cB + kstep, voffB); PG8_STAGE(PG8_SA(1, 0), cA + kstep, voffA); PG8_STAGE(PG8_SB(1, 1), cB + hstep + kstep, voffB);
        PG8_WAIT_V(6); PG8_BAR;
    } else {
        PG8_STAGE(PG8_SB(0, 0), cB, voffB); PG8_STAGE(PG8_SA(0, 0), cA, voffA); PG8_STAGE(PG8_SB(0, 1), cB + hstep, voffB); PG8_STAGE(PG8_SA(0, 1), cA + hstep, voffA);
        if (wr == 1) PG8_BAR;
        PG8_WAIT_V(4); PG8_BAR;
        PG8_STAGE(PG8_SB(1, 0), cB + kstep, voffB); PG8_STAGE(PG8_SA(1, 0), cA + kstep, voffA); PG8_STAGE(PG8_SB(1, 1), cB + hstep + kstep, voffB);
        PG8_WAIT_V(6); PG8_BAR;
    }
    for (;;) {
        const bool has_next = S.next(ui + 1, nxt);
        const char* nA = has_next ? (const char*)g.A + (size_t)nxt.pm * tstep + (size_t)nxt.kt0 * (BK * 2) : cA; const char* nB = has_next ? (const char*)g.Bt + (size_t)nxt.pn * tstep + (size_t)nxt.kt0 * (BK * 2) : cB;
        const int nt = cur.nt;
        asm volatile(".p2align 8" ::: "memory");
        for (int t = 0; t < nt; t += 2) {
            const bool last = (t == nt - 2);
            const char* a1 = cA + (size_t)(t + 1) * kstep;
            const char* a2 = last ? nA : cA + (size_t)(t + 2) * kstep; const char* b2 = last ? nB : cB + (size_t)(t + 2) * kstep;
            const char* a3 = a2 + kstep; const char* b3 = b2 + kstep;
            if (last && has_next) S.a_ready(nxt);
            if constexpr (SP2) {
            PG8_LDB(B0, 0, 0); PG8_LDB(B1, 0, 1); PG8_SCHED; PG8_LDA(At, 0, 0); PG8_STAGE(PG8_SA(1, 1), a1 + hstep, voffA);
            PG8_WAIT_V(8); PG8_WAIT_L(0); PG8_BAR; PG8_MMA(0, 0, At, B0); PG8_MMA(0, 1, At, B1); PG8_BAR; PG8_SCHED;
            PG8_LDA(At, 0, 1); PG8_STAGE(PG8_SB(0, 0), b2, voffB); PG8_STAGE(PG8_SB(0, 1), b2 + hstep, voffB); PG8_STAGE(PG8_SA(0, 0), a2, voffA);
            PG8_WAIT_V(8); PG8_WAIT_L(0); PG8_BAR; PG8_MMA(1, 0, At, B0); PG8_MMA(1, 1, At, B1); PG8_BAR; PG8_SCHED;
            PG8_LDB(B0, 1, 0); PG8_LDB(B1, 1, 1); PG8_SCHED; PG8_LDA(At, 1, 0); PG8_STAGE(PG8_SA(0, 1), a2 + hstep, voffA);
            PG8_WAIT_V(8); PG8_WAIT_L(0); PG8_BAR; PG8_MMA(0, 0, At, B0); PG8_MMA(0, 1, At, B1); PG8_BAR; PG8_SCHED;
            PG8_LDA(At, 1, 1); PG8_STAGE(PG8_SB(1, 0), b3, voffB); PG8_STAGE(PG8_SB(1, 1), b3 + hstep, voffB); PG8_STAGE(PG8_SA(1, 0), a3, voffA);
            PG8_WAIT_V(8); PG8_WAIT_L(0); PG8_BAR; PG8_MMA(1, 0, At, B0); PG8_MMA(1, 1, At, B1); PG8_BAR; PG8_SCHED;
            } else {
            PG8_LDB(B0, 0, 0); PG8_SCHED; PG8_LDA(At, 0, 0); PG8_STAGE(PG8_SA(1, 1), a1 + hstep, voffA);
            PG8_WAIT_L(8); PG8_BAR; PG8_WAIT_L(0); PG8_MMA(0, 0, At, B0); PG8_BAR; PG8_SCHED;
            PG8_LDB(B1, 0, 1); PG8_STAGE(PG8_SB(0, 0), b2, voffB);
            PG8_BAR; PG8_WAIT_L(0); PG8_MMA(0, 1, At, B1); PG8_BAR;
            PG8_LDA(At, 0, 1); PG8_STAGE(PG8_SA(0, 0), a2, voffA);
            PG8_BAR; PG8_WAIT_L(0); PG8_MMA(1, 0, At, B0); PG8_BAR; PG8_SCHED;
            PG8_STAGE(PG8_SB(0, 1), b2 + hstep, voffB);
            PG8_WAIT_V(6); PG8_BAR; PG8_MMA(1, 1, At, B1); PG8_BAR;
            PG8_LDB(B0, 1, 0); PG8_SCHED; PG8_LDA(At, 1, 0); PG8_STAGE(PG8_SA(0, 1), a2 + hstep, voffA);
            PG8_WAIT_L(8); PG8_BAR; PG8_WAIT_L(0); PG8_MMA(0, 0, At, B0); PG8_BAR; PG8_SCHED;
            PG8_LDB(B1, 1, 1); PG8_STAGE(PG8_SB(1, 0), b3, voffB);
            PG8_BAR; PG8_WAIT_L(0); PG8_MMA(0, 1, At, B1); PG8_BAR;
            PG8_LDA(At, 1, 1); PG8_STAGE(PG8_SA(1, 0), a3, voffA);
            PG8_BAR; PG8_WAIT_L(0); PG8_MMA(1, 0, At, B0); PG8_BAR; PG8_SCHED;
            PG8_STAGE(PG8_SB(1, 1), b3 + hstep, voffB);
            PG8_WAIT_V(6); PG8_BAR; PG8_MMA(1, 1, At, B1); PG8_BAR;
            }
        }
        if constexpr (ALIGN_EPI) { if (wr == 0) PG8_BAR; }
        if constexpr (!Epi::AFTER_DRAIN) { E(acc, cur, wr, wc, fr, fq); S.done(cur); }
        if (!has_next) break;
#pragma unroll
        for (int a = 0; a < 2; ++a)
#pragma unroll
            for (int b = 0; b < 2; ++b)
#pragma unroll
                for (int m = 0; m < 4; ++m)
#pragma unroll
                    for (int n = 0; n < 2; ++n) acc[a][b][m][n] = (f32x4){0.f, 0.f, 0.f, 0.f};
        cur = nxt; cA = nA; cB = nB; ++ui;
        if constexpr (ALIGN_EPI) { if (wr == 1) PG8_BAR; }
    }
    PG8_WAIT_V(0);
    if constexpr (!ALIGN_EPI) { if (wr == 0) PG8_BAR; }
    PG8_BAR;
    if constexpr (Epi::AFTER_DRAIN) { E.fused(acc, cur, wr, wc, fr, fq, lds, wid, lane); S.done(cur); }
#undef PG8_SA
#undef PG8_SB
#undef PG8_STAGE
#undef PG8_LDA
#undef PG8_LDB
#undef PG8_MMA
#undef PG8_WAIT_V
#undef PG8_WAIT_L
#undef PG8_BAR
#undef PG8_SCHED
}
}
#ifndef EN_WCVT
#define EN_WCVT 1
#endif
#ifndef EN_GEMM
#define EN_GEMM 1
#endif
#ifndef EN_SCAL
#define EN_SCAL 1
#endif
#ifndef EN_PREP
#define EN_PREP 1
#endif
#ifndef EN_SCANFIN
#define EN_SCANFIN 1
#endif
#ifndef EN_SFA
#define EN_SFA 1
#endif
#ifndef EN_SFB
#define EN_SFB 1
#endif
#ifndef EN_SFC
#define EN_SFC 1
#endif
#ifndef PROBE_Q
#define PROBE_Q -1
#endif
#ifndef PROBE_REPS
#define PROBE_REPS 2
#endif
#ifndef PROBE_SCAL
#define PROBE_SCAL 1
#endif
#ifndef PROBE_SFA
#define PROBE_SFA 1
#endif
#ifndef PROBE_SFB
#define PROBE_SFB 1
#endif
#ifndef PROBE_SFC
#define PROBE_SFC 1
#endif
#ifndef PROBE_DN_W
#define PROBE_DN_W 1
#endif
#ifndef PROBE_DN_Q
#define PROBE_DN_Q 1
#endif
#ifndef PROBE_DN_BAR
#define PROBE_DN_BAR 1
#endif
#ifndef PROBE_DN_LOAD
#define PROBE_DN_LOAD 1
#endif
#ifndef PROBE_DNT
#define PROBE_DNT 0
#endif
#define DNT_K 4ull
#ifndef PROBE_DP1
#define PROBE_DP1 1
#endif
#ifndef PROBE_DP3
#define PROBE_DP3 1
#endif
#ifndef PROBE_DP4
#define PROBE_DP4 1
#endif
#ifndef PROBE_PDN
#define PROBE_PDN 1
#endif
#ifndef PROBE_PRG
#define PROBE_PRG 1
#endif
#ifndef NORM_XBF
#define NORM_XBF 0
#endif
#ifndef PROBE_BAR
#define PROBE_BAR 1
#endif
#ifndef PROBE_DP0
#define PROBE_DP0 1
#endif
#ifndef PROBE_DP5
#define PROBE_DP5 1
#endif
#ifndef EN_NORM
#define EN_NORM 1
#endif
#ifndef MK_SINGLE
#define MK_SINGLE 1
#endif
constexpr int NWAVES = 8;

constexpr int DM = 1024, NB = 8, SEQ = 2048, NDB = 128, DSEQ = 8, DEPTH = 2;
constexpr int MP = NB * SEQ, MS = NDB * DSEQ, M = MP + MS;
constexpr int DFF = 2816, RGW = 512, DNH = 4, DHD = 128, CONVCH = 2048, NPROJ = 3072, INCOLS = 3080;
constexpr float EPS = 1e-6f;
constexpr size_t OFF_Y = 0, OFF_CP = 17825792, OFF_RP = 17924096, OFF_DP = 17932288, OFF_CS = 18980864, OFF_RS = 20553728, OFF_DS = 20684800, OUT_TOTAL = 37462016;
enum { I_XP = 0, I_XS, I_SCONV, I_SRG, I_SDN, I_F1PRE, I_F1UP, I_F1DN, I_F1POST, I_MPRE, I_WIN, I_CONVW, I_CONVB, I_RGWA, I_RGBA, I_RGWX, I_RGBX, I_LAM, I_ALOG, I_DTB, I_DNNW, I_WOUT, I_MPOST,
       I_F2PRE, I_F2UP, I_F2DN, I_F2POST, I_FINAL, N_IN };

constexpr size_t MiB = 1u << 20;
constexpr size_t WS_CTL = 0, CTL_ZERO_BYTES = 1 * MiB;
constexpr size_t WS_W = 2 * MiB;
constexpr size_t WO_UP1 = 0, WO_DN1 = 11534336, WO_WIN = 17301504, WO_WOUT = 23592960, WO_UP2 = 25690112, WO_DN2 = 37224448, WO_END = 42991616;
constexpr size_t WS_XN = 44 * MiB;
constexpr size_t WS_H = 78 * MiB;
constexpr size_t WS_D = 180 * MiB;
constexpr size_t WS_MIX = 248 * MiB;
constexpr size_t WS_SCAL = 282 * MiB;
constexpr size_t WS_XR = 283 * MiB;
constexpr size_t WS_END = 417 * MiB;
static_assert(WS_W + WO_END <= WS_XN && WS_XN + (size_t)M * DM * 2 <= WS_H && WS_H + (size_t)M * NPROJ * 2 <= WS_D && WS_D + (size_t)M * DM * 4 <= WS_MIX && WS_MIX + (size_t)M * DM * 2 <= WS_SCAL && WS_SCAL + (size_t)M * 32 <= WS_XR && WS_XR + (size_t)M * DM * 4 <= WS_END, "d_ws map");
constexpr size_t WS_DSLAB = WS_D + 34 * MiB;
constexpr int NSPLIT_DN = 11, NSPLIT_OUT = 4;
constexpr size_t WS_SST = 351 * MiB;
constexpr int CW_BAR = 4096;

constexpr int RING_BYTES = 131072;
constexpr int LDS_BYTES = 163840;
constexpr int LDSCTL_OFF = LDS_BYTES - 1024, MISC_OFF = LDSCTL_OFF + 320;
static_assert(MISC_OFF + 128 <= LDS_BYTES, "LDS map");

#define GAS __attribute__((address_space(1)))
#define LAS __attribute__((address_space(3)))
typedef unsigned short bf16;
typedef unsigned v4u __attribute__((ext_vector_type(4)));
typedef unsigned v2u __attribute__((ext_vector_type(2)));
typedef float f32x4 __attribute__((ext_vector_type(4)));
typedef GAS unsigned gu32;
typedef GAS unsigned long long gu64;
#define RLX_AGENT __ATOMIC_RELAXED, __HIP_MEMORY_SCOPE_AGENT
#define LDS_WAIT() asm volatile("s_waitcnt lgkmcnt(0)" ::: "memory")
#define VM_WAIT() asm volatile("s_waitcnt vmcnt(0)" ::: "memory")
#define LDS_BARRIER() do { asm volatile("s_waitcnt lgkmcnt(0)" ::: "memory"); __builtin_amdgcn_s_barrier(); asm volatile("" ::: "memory"); } while (0)
__device__ __forceinline__ unsigned f2bf(float f) { unsigned u = __builtin_bit_cast(unsigned, f); return (u + 0x7fffu + ((u >> 16) & 1u)) >> 16; }
__device__ __forceinline__ unsigned pk2(float lo, float hi) { return f2bf(lo) | (f2bf(hi) << 16); }
__device__ __forceinline__ float bf2f(bf16 v) { return __builtin_bit_cast(float, (unsigned)v << 16); }
__device__ __forceinline__ float sigmoid_f(float x) { return __builtin_amdgcn_rcpf(1.0f + __builtin_amdgcn_exp2f(-1.44269504089f * x)); }
__device__ __forceinline__ float silu_ff(float x) { return x * __builtin_amdgcn_rcpf(1.0f + __builtin_amdgcn_exp2f(-1.44269504089f * x)); }
__device__ __forceinline__ float silu_fast(float x) { return x * __builtin_amdgcn_rcpf(1.0f + __builtin_amdgcn_exp2f(-1.44269504089f * x)); }
__device__ __forceinline__ float softplus_f(float x) { return fmaxf(x, 0.0f) + log1pf(__expf(-fabsf(x))); }
__device__ __forceinline__ float gelu_tanh_f(float x) { const float u = 0.7978845608028654f * (x + 0.044715f * x * x * x); return x * sigmoid_f(2.0f * u); }
__device__ __forceinline__ float neg_expm1_f(float e) {
    const float p = -e * (1.0f + e * 0.5f * (1.0f + e * (1.0f / 3.0f) * (1.0f + e * 0.25f * (1.0f + e * 0.2f * (1.0f + e * (1.0f / 6.0f) * (1.0f + e * (1.0f / 7.0f)))))));
    return e > -0.25f ? p : 1.0f - __builtin_amdgcn_exp2f(1.44269504089f * e);
}
#define DPP_ADD(v, ctrl) ((v) + __builtin_bit_cast(float, __builtin_amdgcn_update_dpp(0, __builtin_bit_cast(int, (v)), (ctrl), 0xF, 0xF, true)))
__device__ __forceinline__ float row_sum8(float v) { v = DPP_ADD(v, 0xB1); v = DPP_ADD(v, 0x4E); v = DPP_ADD(v, 0x141); return v; }
__device__ __forceinline__ float row_sum16(float v) { v = row_sum8(v); v = DPP_ADD(v, 0x140); return v; }
__device__ __forceinline__ float wave_sum(float v) {
    v = row_sum16(v);
    const int iv = __builtin_bit_cast(int, v);
    return (__builtin_bit_cast(float, __builtin_amdgcn_readlane(iv, 0)) + __builtin_bit_cast(float, __builtin_amdgcn_readlane(iv, 16))) +
           (__builtin_bit_cast(float, __builtin_amdgcn_readlane(iv, 32)) + __builtin_bit_cast(float, __builtin_amdgcn_readlane(iv, 48)));
}

#define XB_TMO      128
#define XB_XCNT(j)  (256  + 64 * (j))
#define XB_XSUB(j)  (1280 + 64 * (j))
#define XB_XGEN(j)  (2304 + 64 * (j))
#define XB_TOP      3328
#define XB_TOPGEN   3392
#define XCD_BAR_WORDS 3456
#define XB_SPIN_CAP (1u << 18)

__device__ __forceinline__ unsigned xb_ld(unsigned* p)              { return __hip_atomic_load(p, __ATOMIC_RELAXED, __HIP_MEMORY_SCOPE_AGENT); }
__device__ __forceinline__ unsigned xb_add(unsigned* p, unsigned v) { return __hip_atomic_fetch_add(p, v, __ATOMIC_RELAXED, __HIP_MEMORY_SCOPE_AGENT); }
__device__ __forceinline__ unsigned xb_xcc_id() { return (unsigned)__builtin_amdgcn_s_getreg((3 << 11) | 20) & 0xFu; }
#define XB_SPIN(cond, bar) do { unsigned _sp = 0; while (cond) { __builtin_amdgcn_s_sleep(1); \
    if ((++_sp & 255u) == 0u) { if (xb_ld(&(bar)[XB_TMO])) break; if (_sp > XB_SPIN_CAP) { atomicAdd(&(bar)[XB_TMO], 1u); break; } } } } while (0)

struct XcdBarrier {
    unsigned* bar; unsigned x;
    volatile LAS unsigned* st;
};

__device__ __forceinline__ XcdBarrier xcd_barrier_post(unsigned* bar, volatile LAS unsigned* st) {
    XcdBarrier b; b.bar = bar; b.x = xb_xcc_id(); b.st = st;
    if (threadIdx.x == 0) (void)xb_add(&bar[XB_XCNT(b.x)], 1u);
    return b;
}
__device__ __forceinline__ void xcd_barrier_complete(unsigned* bar, unsigned x, unsigned& nloc, unsigned& nx) {
    const unsigned G = gridDim.x * gridDim.y * gridDim.z;
    unsigned sum, cnt, mine, sp = 0u;
    for (;;) {
        sum = 0u; cnt = 0u; mine = 0u;
#pragma unroll
        for (unsigned j = 0; j < 16; ++j) { const unsigned c = xb_ld(&bar[XB_XCNT(j)]); sum += c; cnt += (c > 0u) ? 1u : 0u; mine = (j == x) ? c : mine; }
        if (sum == G) break;
        __builtin_amdgcn_s_sleep(1);
        if ((++sp & 255u) == 0u) { if (xb_ld(&bar[XB_TMO])) break; if (sp > XB_SPIN_CAP) { atomicAdd(&bar[XB_TMO], 1u); break; } }
    }
    nloc = mine > 0u ? mine : 1u; nx = cnt > 0u ? cnt : 1u;
}

__device__ __forceinline__ void xcd_barrier(const XcdBarrier& b) {
    asm volatile("s_waitcnt vmcnt(0)" ::: "memory");
    __syncthreads();
    if (threadIdx.x == 0) {
        unsigned* bar = b.bar;
        __builtin_amdgcn_s_waitcnt(0);
        unsigned nloc = b.st[0], nx = b.st[1];
        if (nloc == 0u) { xcd_barrier_complete(bar, b.x, nloc, nx); b.st[0] = nloc; b.st[1] = nx; }
        const unsigned old = xb_add(&bar[XB_XSUB(b.x)], 1u);
        const unsigned gen = old / nloc;
        if (old + 1u == (gen + 1u) * nloc) {
            __builtin_amdgcn_fence(__ATOMIC_RELEASE, "agent");
            asm volatile("s_waitcnt vmcnt(0)" ::: "memory");
            const unsigned og = xb_add(&bar[XB_TOP], 1u);
            const unsigned tg = og / nx;
            if (og + 1u == (tg + 1u) * nx) xb_add(&bar[XB_TOPGEN], 1u);
            else XB_SPIN(xb_ld(&bar[XB_TOPGEN]) == tg, bar);
            __builtin_amdgcn_fence(__ATOMIC_ACQUIRE, "agent");
            xb_add(&bar[XB_XGEN(b.x)], 1u);
            asm volatile("s_waitcnt vmcnt(0)" ::: "memory");
        } else {
            XB_SPIN(xb_ld(&bar[XB_XGEN(b.x)]) == gen, bar);
            __builtin_amdgcn_fence(__ATOMIC_ACQUIRE, "agent");
            asm volatile("s_waitcnt vmcnt(0)" ::: "memory");
        }
    }
    __syncthreads();
}


constexpr int CW_QUEUE = 2048;
__device__ __forceinline__ int queue_next(gu32* ctr, volatile LAS unsigned* slot, int tid) {
    if (tid == 0) *slot = __hip_atomic_fetch_add(ctr, 1u, RLX_AGENT);
    LDS_BARRIER();
    const int it = (int)*slot;
    LDS_BARRIER();
    return it;
}


struct Args { const float* in[N_IN]; float* out; unsigned char* ws; int ph_lo, ph_hi; };

__device__ __forceinline__ void transpose_item(const float* W, int ldn, int K, bf16* WT, int k0, int n0, int drow0, LAS float* scr, int lane) {
#pragma unroll 8
    for (int i = 0; i < 32; ++i) { const int kk = 2 * i + (lane >> 5); scr[kk * 33 + (lane & 31)] = W[(size_t)(k0 + kk) * ldn + n0 + (lane & 31)]; }
    LDS_WAIT(); asm volatile("" ::: "memory");
    const int c = lane & 7;
#pragma unroll
    for (int j = 0; j < 4; ++j) { const int n = (lane >> 3) + 8 * j; const LAS float* s = scr + (8 * c) * 33 + n;
        v4u o; o.x = pk2(s[0 * 33], s[1 * 33]); o.y = pk2(s[2 * 33], s[3 * 33]); o.z = pk2(s[4 * 33], s[5 * 33]); o.w = pk2(s[6 * 33], s[7 * 33]);
        *(GAS v4u*)(WT + (size_t)(drow0 + n) * K + k0 + 8 * c) = o; }
    LDS_WAIT(); asm volatile("" ::: "memory");
}
__device__ __forceinline__ int map_up_row(int n) { return n < DFF ? ((n >> 7) << 8) + (n & 127) : (((n - DFF) >> 7) << 8) + 128 + ((n - DFF) & 127); }

constexpr int WI_UP = 16 * 176, WI_DN = 44 * 32, WI_IN = 16 * 96, WI_OUT = 16 * 32;
constexpr int WI_0 = 0, WI_1 = WI_UP + WI_DN  , WI_2 = WI_1 + WI_IN  , WI_3 = WI_2 + WI_OUT + WI_UP + WI_DN  ;
__device__ __forceinline__ void wcvt_range(const Args& a, int l, int it_lo, int it_hi, int worker, int nworkers, LAS unsigned char* lds, int wave, int lane) {
    LAS float* scr = (LAS float*)(lds + wave * 16384);
    bf16* wbase = (bf16*)(a.ws + WS_W);
    constexpr int I_UP = WI_UP, I_DN = WI_DN, I_IN = WI_IN, I_OUT = WI_OUT;
    for (int it = it_lo + worker; it < it_hi; it += nworkers) {
        int r = it; const float* W; int ldn, K, nblk; size_t wo; bool up = false;
        if (r < I_UP) { W = a.in[I_F1UP] + (size_t)l * DM * 2 * DFF; ldn = 2 * DFF; K = DM; nblk = 176; wo = WO_UP1; up = true; }
        else if ((r -= I_UP) < I_DN) { W = a.in[I_F1DN] + (size_t)l * DFF * DM; ldn = DM; K = DFF; nblk = 32; wo = WO_DN1; }
        else if ((r -= I_DN) < I_IN) { W = a.in[I_WIN] + (size_t)l * DM * INCOLS; ldn = INCOLS; K = DM; nblk = 96; wo = WO_WIN; }
        else if ((r -= I_IN) < I_OUT) { W = a.in[I_WOUT] + (size_t)l * DM * DM; ldn = DM; K = DM; nblk = 32; wo = WO_WOUT; }
        else if ((r -= I_OUT) < I_UP) { W = a.in[I_F2UP] + (size_t)l * DM * 2 * DFF; ldn = 2 * DFF; K = DM; nblk = 176; wo = WO_UP2; up = true; }
        else { r -= I_UP; W = a.in[I_F2DN] + (size_t)l * DFF * DM; ldn = DM; K = DFF; nblk = 32; wo = WO_DN2; }
        const int kb = r / nblk, nb = r % nblk, n0 = 32 * nb;
        transpose_item(W, ldn, K, (bf16*)((unsigned char*)wbase + wo), 64 * kb, n0, up ? map_up_row(n0) : n0, scr, lane);
    }
}

__device__ __forceinline__ const float* x_in_row(const Args& a, int m) { return m < MP ? a.in[I_XP] + (size_t)m * DM : a.in[I_XS] + (size_t)(m - MP) * DM; }

__device__ __forceinline__ void xn0_phase(const Args& a, int wave, int lane) {
    const int gw = blockIdx.x * NWAVES + wave, NGW = gridDim.x * NWAVES;
    const float* g = a.in[I_F1PRE];
    f32x4 gv[4];
#pragma unroll
    for (int j = 0; j < 4; ++j) gv[j] = ((const f32x4*)g)[lane + 64 * j];
    for (int m = gw; m < M; m += NGW) {
        const f32x4* xr = (const f32x4*)x_in_row(a, m) + lane;
        f32x4 v[4]; float s = 0.f;
#pragma unroll
        for (int j = 0; j < 4; ++j) { v[j] = xr[64 * j]; s += (v[j].x * v[j].x + v[j].y * v[j].y) + (v[j].z * v[j].z + v[j].w * v[j].w); }
        const float rstd = rsqrtf(wave_sum(s) * (1.0f / DM) + EPS);
        unsigned long long* o8 = (unsigned long long*)((bf16*)(a.ws + WS_XN) + (size_t)m * DM) + lane;
#pragma unroll
        for (int j = 0; j < 4; ++j) { const f32x4 y = v[j] * rstd * gv[j]; o8[64 * j] = (unsigned long long)pk2(y.x, y.y) | ((unsigned long long)pk2(y.z, y.w) << 32); }
    }
}

__device__ __forceinline__ f32x4 bf4_to_f32(v2u w) { return (f32x4){__builtin_bit_cast(float, w.x << 16), __builtin_bit_cast(float, w.x & 0xffff0000u), __builtin_bit_cast(float, w.y << 16), __builtin_bit_cast(float, w.y & 0xffff0000u)}; }
__device__ __forceinline__ void norm_phase(const Args& a, const float* gpost, const float* gnext, float alpha, int kn, bool last, int nsplit, int wave, int lane) {
    const int gw = blockIdx.x * NWAVES + wave, NGW = gridDim.x * NWAVES;
    f32x4 gp[4], gn[4];
#pragma unroll
    for (int j = 0; j < 4; ++j) { gp[j] = ((const f32x4*)gpost)[lane + 64 * j]; gn[j] = ((const f32x4*)gnext)[lane + 64 * j]; }
    const bf16* D = (const bf16*)(a.ws + WS_D);
    const float* xsrc = (kn & 1) ? (const float*)(a.ws + WS_XR) : a.out + OFF_Y;
    float* xdst = (kn & 1) ? a.out + OFF_Y : (float*)(a.ws + WS_XR);
#if NORM_XBF
    const bf16* xsb = (const bf16*)(a.ws + WS_XR) + (size_t)(kn & 1) * M * DM;
    bf16* xdb = (bf16*)(a.ws + WS_XR) + (size_t)((kn + 1) & 1) * M * DM;
#endif
    constexpr int NR = 4;
    for (int m0 = gw; m0 < M; m0 += NR * NGW) {
        f32x4 d[NR][4], x[NR][4]; float s[NR];
#pragma unroll
        for (int rr = 0; rr < NR; ++rr) { const int m = m0 + rr * NGW; s[rr] = 0.f;
            if (m < M) {
                const v2u* dr = (const v2u*)(D + (size_t)m * DM) + lane;
                const f32x4* xr = (kn == 0 ? (const f32x4*)x_in_row(a, m) : (const f32x4*)(xsrc + (size_t)m * DM)) + lane;
#pragma unroll
                for (int j = 0; j < 4; ++j) {
#if NORM_XBF
                    x[rr][j] = kn == 0 ? xr[64 * j] : bf4_to_f32(((const v2u*)(xsb + (size_t)m * DM) + lane)[64 * j]);
#else
                    x[rr][j] = xr[64 * j];
#endif
                    if (m < MP) d[rr][j] = bf4_to_f32(dr[64 * j]);
                    else { d[rr][j] = (f32x4){0.f, 0.f, 0.f, 0.f};
                        for (int sp = 0; sp < nsplit; ++sp) d[rr][j] += bf4_to_f32(((const v2u*)((const bf16*)(a.ws + WS_DSLAB) + ((size_t)sp * MS + (m - MP)) * DM) + lane)[64 * j]); }
                    s[rr] += (d[rr][j].x * d[rr][j].x + d[rr][j].y * d[rr][j].y) + (d[rr][j].z * d[rr][j].z + d[rr][j].w * d[rr][j].w); } } }
#pragma unroll
        for (int rr = 0; rr < NR; ++rr) { const int m = m0 + rr * NGW;
            if (m < M) {
                const float rs = alpha * rsqrtf(wave_sum(s[rr]) * (1.0f / DM) + EPS);
                float s2 = 0.f;
#pragma unroll
                for (int j = 0; j < 4; ++j) { x[rr][j] = x[rr][j] + d[rr][j] * rs * gp[j]; s2 += (x[rr][j].x * x[rr][j].x + x[rr][j].y * x[rr][j].y) + (x[rr][j].z * x[rr][j].z + x[rr][j].w * x[rr][j].w); }
                const float rs2 = rsqrtf(wave_sum(s2) * (1.0f / DM) + EPS);
                f32x4* xo = (f32x4*)((NORM_XBF && last ? a.out + OFF_Y : xdst) + (size_t)m * DM) + lane;
                if (last) {
#pragma unroll
                    for (int j = 0; j < 4; ++j) xo[64 * j] = x[rr][j] * rs2 * gn[j];
                } else {
                    v2u* o8 = (v2u*)((bf16*)(a.ws + WS_XN) + (size_t)m * DM) + lane;
#pragma unroll
                    for (int j = 0; j < 4; ++j) {
#if NORM_XBF
                        { v2u xw; xw.x = pk2(x[rr][j].x, x[rr][j].y); xw.y = pk2(x[rr][j].z, x[rr][j].w); ((v2u*)(xdb + (size_t)m * DM) + lane)[64 * j] = xw; }
#else
                        xo[64 * j] = x[rr][j];
#endif
                        const f32x4 y = x[rr][j] * rs2 * gn[j]; v2u yw; yw.x = pk2(y.x, y.y); yw.y = pk2(y.z, y.w); o8[64 * j] = yw; }
                }
            } }
    }
}

__device__ __forceinline__ void scal_phase(const Args& a, int l, LAS unsigned char* lds, int tid, int wave, int lane) {
    const int gw = blockIdx.x * NWAVES + wave, NGW = gridDim.x * NWAVES;
    const float* wl = a.in[I_WIN] + (size_t)l * DM * INCOLS + NPROJ;
    LAS float* wsm = (LAS float*)lds;
#pragma unroll
    for (int n = 0; n < 4; ++n) { const int p = tid + 512 * n; *(LAS f32x4*)(wsm + 4 * p + 4 * (p >> 4)) = *(const f32x4*)(wl + (size_t)(p >> 1) * INCOLS + 4 * (p & 1)); }
    __syncthreads();
    const bf16* XN = (const bf16*)(a.ws + WS_XN);
    float* SC = (float*)(a.ws + WS_SCAL);
    for (int m = gw; m < M; m += NGW) {
        float acc[8];
#pragma unroll
        for (int j = 0; j < 8; ++j) acc[j] = 0.f;
#pragma unroll
        for (int jj = 0; jj < 2; ++jj) {
            const int k0 = 8 * lane + 512 * jj;
            const v4u x0 = *(const v4u*)(XN + (size_t)m * DM + k0);
            const unsigned xw[4] = {x0.x, x0.y, x0.z, x0.w};
#pragma unroll
            for (int i = 0; i < 8; ++i) {
                const float xv = (i & 1) ? __builtin_bit_cast(float, xw[i >> 1] & 0xffff0000u) : __builtin_bit_cast(float, xw[i >> 1] << 16);
                const f32x4 w0 = *(const LAS f32x4*)(wsm + (k0 + i) * 8 + (k0 >> 1)), w1 = *(const LAS f32x4*)(wsm + (k0 + i) * 8 + (k0 >> 1) + 4);
                acc[0] += xv * w0.x; acc[1] += xv * w0.y; acc[2] += xv * w0.z; acc[3] += xv * w0.w;
                acc[4] += xv * w1.x; acc[5] += xv * w1.y; acc[6] += xv * w1.z; acc[7] += xv * w1.w;
            }
        }
#pragma unroll
        for (int j = 0; j < 8; ++j) acc[j] = wave_sum(acc[j]);
        if (lane == 0) { f32x4* o = (f32x4*)(SC + (size_t)m * 8); o[0] = (f32x4){acc[0], acc[1], acc[2], acc[3]}; o[1] = (f32x4){acc[4], acc[5], acc[6], acc[7]}; }
    }
    __syncthreads();
}

__device__ __forceinline__ float conv_src(const Args& a, int l, int m, int ch, int back) {
    const bf16* PROJ = (const bf16*)(a.ws + WS_H);
    const int t = m < MP ? (m & (SEQ - 1)) : ((m - MP) & (DSEQ - 1));
    const int ts = t - back;
    if (ts >= 0) return bf2f(PROJ[(size_t)(m - back) * NPROJ + ch]);
    if (m < MP) return 0.f;
    const int bs = (m - MP) >> 3;
    return a.in[I_SCONV][((size_t)(l * NDB + bs) * 3 + (3 + ts)) * CONVCH + ch];
}

__device__ __forceinline__ void delta_seq(const Args& a, int l, int item, LAS unsigned char* lds, int tid) {
    asm volatile("" : "+v"(tid));
    LAS float* qs = (LAS float*)lds;
    LAS float* ks = qs + 256;
    LAS float* red = ks + 256;
    LAS float* red2 = red + 16;
    const int bs = item >> 1, hl = __builtin_amdgcn_readfirstlane(tid >> 8), h = 2 * (item & 1) + hl, e = (tid & 255) >> 1, half = tid & 1, lane = tid & 63, wave = __builtin_amdgcn_readfirstlane(tid >> 6);
    const int m0 = MP + bs * DSEQ, chq = 512 + h * 128 + e;
    float s[64];
    { const float* S0 = a.in[I_SDN] + (((size_t)(l * NDB + bs) * DNH + h) << 14) + (size_t)(64 * half) * 128 + e;
#pragma unroll
      for (int d = 0; d < 64; ++d) s[d] = S0[d * 128]; }
    const float* cw = a.in[I_CONVW] + (size_t)l * 4 * CONVCH;
    float wq[4], wk[4], wv[4], hq[3], hk[3], hv[3];
#pragma unroll
    for (int t = 0; t < 4; ++t) { wq[t] = cw[t * CONVCH + chq]; wk[t] = cw[t * CONVCH + 512 + chq]; wv[t] = cw[t * CONVCH + 1024 + chq]; }
#pragma unroll
    for (int r = 0; r < 3; ++r) { const float* sc = a.in[I_SCONV] + ((size_t)(l * NDB + bs) * 3 + r) * CONVCH; hq[r] = sc[chq]; hk[r] = sc[512 + chq]; hv[r] = sc[1024 + chq]; }
    const float negA = -__expf(a.in[I_ALOG][l * DNH + h]), dtb = a.in[I_DTB][l * DNH + h], nw = a.in[I_DNNW][l * DHD + e];
    const bf16* PROJ = (const bf16*)(a.ws + WS_H); const float* SC = (const float*)(a.ws + WS_SCAL); bf16* MIX = (bf16*)(a.ws + WS_MIX);
    for (int t = 0; t < DSEQ; ++t) {
        const int m = m0 + t; const bf16* prow = PROJ + (size_t)m * NPROJ;
        const float xq = bf2f(prow[chq]), xk = bf2f(prow[512 + chq]), xv = bf2f(prow[1024 + chq]), z = bf2f(prow[2048 + chq]);
        const float sb = SC[(size_t)m * 8 + h], sg = SC[(size_t)m * 8 + 4 + h];
        const float cq = wq[0] * hq[0] + wq[1] * hq[1] + wq[2] * hq[2] + wq[3] * xq; hq[0] = hq[1]; hq[1] = hq[2]; hq[2] = xq;
        const float ck = wk[0] * hk[0] + wk[1] * hk[1] + wk[2] * hk[2] + wk[3] * xk; hk[0] = hk[1]; hk[1] = hk[2]; hk[2] = xk;
        const float cv = wv[0] * hv[0] + wv[1] * hv[1] + wv[2] * hv[2] + wv[3] * xv; hv[0] = hv[1]; hv[1] = hv[2]; hv[2] = xv;
        const float sq_ = silu_ff(cq), sk = silu_ff(ck), sv = silu_ff(cv);
        const float ssq = wave_sum(half ? 0.f : sq_ * sq_), ssk = wave_sum(half ? 0.f : sk * sk);
        if (lane == 0) { red[wave * 2] = ssq; red[wave * 2 + 1] = ssk; }
        LDS_BARRIER();
        const float tq = (red[8 * hl] + red[8 * hl + 2]) + (red[8 * hl + 4] + red[8 * hl + 6]), tk = (red[8 * hl + 1] + red[8 * hl + 3]) + (red[8 * hl + 5] + red[8 * hl + 7]);
        if (!half) { qs[hl * 128 + e] = sq_ * rsqrtf(tq + EPS) * 0.08838834764831845f; ks[hl * 128 + e] = sk * rsqrtf(tk + EPS); }
        LDS_BARRIER();
        const float beta = sigmoid_f(sb), eg = __expf(negA * softplus_f(sg + dtb));
        const LAS float* kh = ks + hl * 128 + 64 * half; const LAS float* qh = qs + hl * 128 + 64 * half;
        float dot = 0.f;
#pragma unroll
        for (int d = 0; d < 64; d += 4) { const f32x4 k4 = *(const LAS f32x4*)(kh + d); dot += k4.x * s[d] + k4.y * s[d + 1] + k4.z * s[d + 2] + k4.w * s[d + 3]; }
        dot += __shfl_xor(dot, 1);
        const float c = beta * (sv - eg * dot);
        float o = 0.f;
#pragma unroll
        for (int d = 0; d < 64; d += 4) { const f32x4 k4 = *(const LAS f32x4*)(kh + d); const f32x4 q4 = *(const LAS f32x4*)(qh + d);
            s[d] = eg * s[d] + k4.x * c; s[d + 1] = eg * s[d + 1] + k4.y * c; s[d + 2] = eg * s[d + 2] + k4.z * c; s[d + 3] = eg * s[d + 3] + k4.w * c;
            o += q4.x * s[d] + q4.y * s[d + 1] + q4.z * s[d + 2] + q4.w * s[d + 3]; }
        o += __shfl_xor(o, 1);
        const float sso = wave_sum(half ? 0.f : o * o);
        if (lane == 0) red2[wave] = sso;
        LDS_BARRIER();
        const float rstd = rsqrtf(((red2[4 * hl] + red2[4 * hl + 1]) + (red2[4 * hl + 2] + red2[4 * hl + 3])) * (1.0f / DHD) + EPS);
        if (!half) MIX[(size_t)m * DM + chq] = (bf16)f2bf(o * rstd * nw * silu_ff(z));
    }
    float* So = a.out + OFF_DS + (((size_t)(l * NDB + bs) * DNH + h) << 14) + (size_t)(64 * half) * 128 + e;
#pragma unroll
    for (int d = 0; d < 64; ++d) So[d * 128] = s[d];
    LDS_BARRIER();
}

constexpr size_t DI_W = WS_D, DI_QG = WS_D + 16 * MiB, DI_KGT = WS_D + 32 * MiB, DI_U = WS_D + 48 * MiB, DI_ATT = WS_XN, DI_EGL = WS_XN + 8 * MiB;
typedef short bf16x8v __attribute__((ext_vector_type(8)));
typedef float f32x2_t __attribute__((ext_vector_type(2)));
typedef __bf16 bf16x2_t __attribute__((ext_vector_type(2)));
__device__ __forceinline__ unsigned cvtpk_s(float lo, float hi) { f32x2_t v = {lo, hi}; bf16x2_t b = __builtin_convertvector(v, bf16x2_t); return __builtin_bit_cast(unsigned, b); }
__device__ __forceinline__ bf16x8v pack8(const f32x4 lo4, const f32x4 hi4) { v4u w; w.x = cvtpk_s(lo4[0], lo4[1]); w.y = cvtpk_s(lo4[2], lo4[3]); w.z = cvtpk_s(hi4[0], hi4[1]); w.w = cvtpk_s(hi4[2], hi4[3]); return __builtin_bit_cast(bf16x8v, w); }
__device__ __forceinline__ int perm32k(int x) { return 8 * ((x >> 2) & 3) + 4 * (x >> 4) + (x & 3); }

constexpr int VBSTR = 136, RAWSTR = 392, ASTR = 68, TDSTR = 20;
constexpr int DP_QB = 0, DP_KB = 17408, DP_VB = 34816, DP_AM = 52224, DP_RAW = 52224, DP_GS = DP_RAW + 67 * RAWSTR * 2, DP_BS = DP_GS + 256, DP_CW = DP_BS + 256, DP_TD = DP_CW + 6144, DP_END = DP_TD + 4 * 16 * TDSTR * 4;
static_assert(DP_VB + 64 * VBSTR * 2 <= DP_AM && DP_END <= LDSCTL_OFF && DP_GS % 16 == 0, "DNPREP LDS map");
__device__ __forceinline__ void dnprep_item(const Args& a, int l, int it, LAS unsigned char* lds, int tid) {
    asm volatile("" : "+v"(tid));
    LAS bf16* qb = (LAS bf16*)(lds + DP_QB);
    LAS bf16* kb = (LAS bf16*)(lds + DP_KB);
    LAS bf16* vb = (LAS bf16*)(lds + DP_VB);
    LAS float* Am = (LAS float*)(lds + DP_AM);
    LAS float* Td = (LAS float*)(lds + DP_TD);
    LAS bf16* raw = (LAS bf16*)(lds + DP_RAW);
    LAS float* Gs = (LAS float*)(lds + DP_GS);
    LAS float* bs = (LAS float*)(lds + DP_BS);
    LAS float* cw = (LAS float*)(lds + DP_CW);
    const int lane = tid & 63, wave = __builtin_amdgcn_readfirstlane(tid >> 6), q4 = lane >> 4, r16 = lane & 15;
    const int c = it & 31, h = (it >> 5) & 3, b = it >> 7;
    const bf16* PROJ = (const bf16*)(a.ws + WS_H);
    const int mbase = b * SEQ + 64 * c;
    _Pragma("unroll 1") for (int pr0 = 0; pr0 < PROBE_DP0; ++pr0) {
        if (pr0 > 0) LDS_BARRIER();
        v4u pv[7];
#pragma unroll
        for (int n = 0; n < 7; ++n) { const int p = tid + 512 * n; pv[n] = (v4u){0u, 0u, 0u, 0u};
            if (p < 67 * 48) { const int slot = p / 48, pc = p - slot * 48;
                if (64 * c + slot - 3 >= 0) pv[n] = *(const v4u*)(PROJ + (size_t)(mbase - 3 + slot) * NPROJ + 512 * (1 + (pc >> 4)) + 128 * h + 8 * (pc & 15)); } }
        f32x4 wv = (f32x4){0.f, 0.f, 0.f, 0.f};
        if (tid < 384) { const int which = tid >> 7, tap = (tid >> 5) & 3, f4 = tid & 31; wv = *(const f32x4*)(a.in[I_CONVW] + ((size_t)l * 4 + tap) * CONVCH + 512 * (1 + which) + 128 * h + 4 * f4); }
        if (wave == 0) {
            const float* SC = (const float*)(a.ws + WS_SCAL) + (size_t)(mbase + lane) * 8;
            const float beta = sigmoid_f(SC[h]);
            float G = -__expf(a.in[I_ALOG][l * DNH + h]) * softplus_f(SC[4 + h] + a.in[I_DTB][l * DNH + h]);
#pragma unroll
            for (int off = 1; off < 64; off <<= 1) { const float tt = __shfl_up(G, off); if (lane >= off) G += tt; }
            Gs[lane] = G; bs[lane] = beta;
            if (lane == 63) ((float*)(a.ws + DI_EGL))[it] = __expf(G);
        }
#pragma unroll
        for (int n = 0; n < 7; ++n) { const int p = tid + 512 * n; if (p < 67 * 48) { const int slot = p / 48, pc = p - slot * 48; *(LAS v4u*)(raw + slot * RAWSTR + 8 * pc) = pv[n]; } }
        if (tid < 384) *(LAS f32x4*)(cw + 4 * tid) = wv;
    }
    LDS_BARRIER();
    _Pragma("unroll 1") for (int pr1 = 0; pr1 < PROBE_DP1; ++pr1) {
        const int i = tid >> 3, sub = tid & 7;
#pragma unroll
        for (int which = 0; which < 3; ++which) {
            float o[16];
#pragma unroll
            for (int x = 0; x < 16; ++x) o[x] = 0.f;
#pragma unroll
            for (int tap = 0; tap < 4; ++tap) {
                const LAS v4u* xp = (const LAS v4u*)(raw + (i + tap) * RAWSTR + which * 128 + 16 * sub);
                const v4u x0 = xp[0], x1 = xp[1];
                const LAS f32x4* wp = (const LAS f32x4*)(cw + (which * 4 + tap) * 128 + 16 * sub);
                const f32x4 w0 = wp[0], w1 = wp[1], w2 = wp[2], w3 = wp[3];
                const unsigned xw[8] = {x0.x, x0.y, x0.z, x0.w, x1.x, x1.y, x1.z, x1.w};
                const float wv[16] = {w0.x, w0.y, w0.z, w0.w, w1.x, w1.y, w1.z, w1.w, w2.x, w2.y, w2.z, w2.w, w3.x, w3.y, w3.z, w3.w};
#pragma unroll
                for (int x = 0; x < 16; ++x) { const float xv = (x & 1) ? __builtin_bit_cast(float, xw[x >> 1] & 0xffff0000u) : __builtin_bit_cast(float, xw[x >> 1] << 16); o[x] += wv[x] * xv; }
            }
            float ss = 0.f;
#pragma unroll
            for (int x = 0; x < 16; ++x) { o[x] = silu_ff(o[x]); ss += o[x] * o[x]; }
            ss = row_sum8(ss);
            const float sc = which == 0 ? __builtin_amdgcn_rsqf(ss + EPS) * 0.08838834764831845f : (which == 1 ? __builtin_amdgcn_rsqf(ss + EPS) : 1.0f);
            v4u w0, w1; w0.x = cvtpk_s(o[0] * sc, o[1] * sc); w0.y = cvtpk_s(o[2] * sc, o[3] * sc); w0.z = cvtpk_s(o[4] * sc, o[5] * sc); w0.w = cvtpk_s(o[6] * sc, o[7] * sc);
            w1.x = cvtpk_s(o[8] * sc, o[9] * sc); w1.y = cvtpk_s(o[10] * sc, o[11] * sc); w1.z = cvtpk_s(o[12] * sc, o[13] * sc); w1.w = cvtpk_s(o[14] * sc, o[15] * sc);
            LAS v4u* dst = (LAS v4u*)((which == 0 ? qb : (which == 1 ? kb : vb)) + i * VBSTR + 16 * sub); dst[0] = w0; dst[1] = w1;
            asm volatile("" ::: "memory");
        }
    }
    LDS_BARRIER();
    bf16* ATT = (bf16*)(a.ws + DI_ATT) + (size_t)it * 4096;
    _Pragma("unroll 1") for (int pr3 = 0; pr3 < PROBE_DP3; ++pr3)
    for (int jb = wave; jb < 26; jb += 8) {
        if (jb >= 20) {
            const int z = jb - 20, ti = z < 3 ? 0 : (z < 5 ? 1 : 2), tj = z < 3 ? z + 1 : (z < 5 ? z - 1 : 3);
#pragma unroll
            for (int r = 0; r < 4; ++r) { const int i = 16 * ti + 4 * q4 + r, j = 16 * tj + r16; ATT[i * 64 + (j & 32) + perm32k(j & 31)] = (bf16)0; }
            continue;
        }
        const bool iskk = jb < 10; const int jl = iskk ? jb : jb - 10;
        const int ti = jl >= 6 ? 3 : (jl >= 3 ? 2 : (jl >= 1 ? 1 : 0)), tj = jl - (ti * (ti + 1)) / 2;
        const LAS bf16* X = (iskk ? kb : qb) + (16 * ti + r16) * VBSTR + 8 * q4;
        const LAS bf16* Kp = kb + (16 * tj + r16) * VBSTR + 8 * q4;
        bf16x8v xa[4], kf[4];
#pragma unroll
        for (int kk = 0; kk < 4; ++kk) { xa[kk] = *(const LAS bf16x8v*)(X + 32 * kk); kf[kk] = *(const LAS bf16x8v*)(Kp + 32 * kk); }
        f32x4 acc = (f32x4){0.f, 0.f, 0.f, 0.f};
#pragma unroll
        for (int kk = 0; kk < 4; ++kk) acc = __builtin_amdgcn_mfma_f32_16x16x32_bf16(xa[kk], kf[kk], acc, 0, 0, 0);
        const int j = 16 * tj + r16; const float Gj = Gs[j];
#pragma unroll
        for (int r = 0; r < 4; ++r) { const int i = 16 * ti + 4 * q4 + r;
            const float dec = __expf(i >= j ? Gs[i] - Gj : 0.f);
            if (iskk) Am[i * ASTR + j] = i > j ? bs[i] * acc[r] * dec : 0.f;
            else ATT[i * 64 + (j & 32) + perm32k(j & 31)] = (bf16)f2bf(i >= j ? acc[r] * dec : 0.f); }
    }
    LDS_BARRIER();
    _Pragma("unroll 1") for (int pr4 = 0; pr4 < PROBE_DP4; ++pr4) {
    if (wave == 0) {
        const int bb = lane >> 4, cc = lane & 15;
        const LAS float* Ab = Am + (16 * bb) * ASTR + 16 * bb;
        float x[16];
#pragma unroll
        for (int i = 0; i < 16; ++i) {
            float acc = (i == cc) ? 1.0f : 0.0f;
#pragma unroll
            for (int j4 = 0; 4 * j4 < i; ++j4) { const f32x4 a4 = *(const LAS f32x4*)(Ab + i * ASTR + 4 * j4);
                acc -= a4.x * x[4 * j4];
                if (4 * j4 + 1 < i) acc -= a4.y * x[4 * j4 + 1];
                if (4 * j4 + 2 < i) acc -= a4.z * x[4 * j4 + 2];
                if (4 * j4 + 3 < i) acc -= a4.w * x[4 * j4 + 3]; }
            x[i] = acc;
            Td[(bb * 16 + i) * TDSTR + cc] = acc;
        }
    } else {
        bf16* QG = (bf16*)(a.ws + DI_QG) + (size_t)it * 8192; bf16* KGT = (bf16*)(a.ws + DI_KGT) + (size_t)it * 8192; const float G63 = Gs[63];
        for (int p = tid - 64; p < 1024; p += 448) {
            { const int i = p >> 4, g32 = (p >> 2) & 3, q = p & 3; const float eg = __expf(Gs[i]);
              const v2u lo2 = *(const LAS v2u*)(qb + i * VBSTR + 32 * g32 + 4 * q), hi2 = *(const LAS v2u*)(qb + i * VBSTR + 32 * g32 + 16 + 4 * q);
              *(v4u*)(QG + i * 128 + 32 * g32 + 8 * q) = __builtin_bit_cast(v4u, pack8(bf4_to_f32(lo2) * eg, bf4_to_f32(hi2) * eg)); }
            { const int dd = p >> 3, g32 = (p >> 2) & 1, q = p & 3;
              f32x4 lo, hi;
#pragma unroll
              for (int x = 0; x < 4; ++x) { const int t0 = 32 * g32 + 4 * q + x, t1 = t0 + 16; lo[x] = bf2f(kb[t0 * VBSTR + dd]) * __expf(G63 - Gs[t0]); hi[x] = bf2f(kb[t1 * VBSTR + dd]) * __expf(G63 - Gs[t1]); }
              *(v4u*)(KGT + dd * 64 + 32 * g32 + 8 * q) = __builtin_bit_cast(v4u, pack8(lo, hi)); } }
    }
    LDS_BARRIER();
    {
        const bool isu = wave < 4;
        const LAS bf16* src = isu ? vb : kb;
        bf16* dbase = isu ? (bf16*)(a.ws + DI_U) + (size_t)it * 8192 : (bf16*)(a.ws + DI_W) + (size_t)it * 8192;
        int ccol[2], dcol[2];
#pragma unroll
        for (int ct = 0; ct < 2; ++ct) { ccol[ct] = (32 * wave + 16 * ct + r16) & 127; dcol[ct] = isu ? ccol[ct] : (ccol[ct] & 96) + perm32k(ccol[ct] & 31); }
        f32x4 X[2][4];
#pragma unroll
        for (int bq = 0; bq < 4; ++bq) {
            f32x4 acc[2]; acc[0] = (f32x4){0.f, 0.f, 0.f, 0.f}; acc[1] = acc[0];
#pragma unroll
            for (int j = 0; j < bq; ++j) { const f32x4 a4 = *(const LAS f32x4*)(Am + (16 * bq + r16) * ASTR + 16 * j + 4 * q4);
#pragma unroll
                for (int ct = 0; ct < 2; ++ct) {
                    acc[ct] = __builtin_amdgcn_mfma_f32_16x16x4f32(a4.x, X[ct][j][0], acc[ct], 0, 0, 0); acc[ct] = __builtin_amdgcn_mfma_f32_16x16x4f32(a4.y, X[ct][j][1], acc[ct], 0, 0, 0);
                    acc[ct] = __builtin_amdgcn_mfma_f32_16x16x4f32(a4.z, X[ct][j][2], acc[ct], 0, 0, 0); acc[ct] = __builtin_amdgcn_mfma_f32_16x16x4f32(a4.w, X[ct][j][3], acc[ct], 0, 0, 0); } }
            const f32x4 t4 = *(const LAS f32x4*)(Td + (bq * 16 + r16) * TDSTR + 4 * q4);
#pragma unroll
            for (int ct = 0; ct < 2; ++ct) {
                f32x4 y;
#pragma unroll
                for (int r = 0; r < 4; ++r) { const int i = 16 * bq + 4 * q4 + r; float rv = bf2f(src[i * VBSTR + ccol[ct]]) * bs[i]; if (!isu) rv *= __expf(Gs[i]); y[r] = rv - acc[ct][r]; }
                f32x4 xx = (f32x4){0.f, 0.f, 0.f, 0.f};
                xx = __builtin_amdgcn_mfma_f32_16x16x4f32(t4.x, y[0], xx, 0, 0, 0); xx = __builtin_amdgcn_mfma_f32_16x16x4f32(t4.y, y[1], xx, 0, 0, 0);
                xx = __builtin_amdgcn_mfma_f32_16x16x4f32(t4.z, y[2], xx, 0, 0, 0); xx = __builtin_amdgcn_mfma_f32_16x16x4f32(t4.w, y[3], xx, 0, 0, 0);
                X[ct][bq] = xx;
#pragma unroll
                for (int r = 0; r < 4; ++r) dbase[(16 * bq + 4 * q4 + r) * 128 + dcol[ct]] = (bf16)f2bf(xx[r]);
            }
        }
    }
    }
    LDS_BARRIER();
}

constexpr int DNB_W = 0, DNB_QG = 16384, DNB_KGT = 32768, DNB_ATT = 49152, DNB_BYTES = 57344, DNB_U = 2 * DNB_BYTES, DNB_O = DNB_U + 16384, OSTR = 136, DNB_NW = DNB_O + 64 * OSTR * 2, DNB_END = DNB_NW + 512;
static_assert(DNB_END <= LDSCTL_OFF, "DNSCAN LDS map");
__device__ __forceinline__ void dnscan_wg(const Args& a, int l, int bh, int c0, int c1, LAS unsigned char* lds, int tid) {
    const int lane = tid & 63, wave = __builtin_amdgcn_readfirstlane(tid >> 6), q4 = lane >> 4, r16 = lane & 15;
    const int b = bh >> 2, h = bh & 3;
    const bf16* PROJ = (const bf16*)(a.ws + WS_H); bf16* MIX = (bf16*)(a.ws + WS_MIX);
    if (wave < 4) {
        f32x4 S[2][8];
        f32x4* sst = (f32x4*)(a.ws + WS_SST) + (size_t)bh * 16 * 256 + tid;
#pragma unroll
        for (int ct = 0; ct < 2; ++ct)
#pragma unroll
            for (int j = 0; j < 8; ++j) S[ct][j] = c0 > 0 ? sst[256 * (8 * ct + j)] : (f32x4){0.f, 0.f, 0.f, 0.f};
        int fA[4], fB[2];
#pragma unroll
        for (int kk = 0; kk < 4; ++kk) fA[kk] = r16 * 256 + (((4 * kk + q4) ^ r16) << 4);
#pragma unroll
        for (int k2 = 0; k2 < 2; ++k2) fB[k2] = r16 * 128 + (((4 * k2 + q4) ^ ((r16 >> 1) & 7)) << 4);
        int uoff[2][4];
#pragma unroll
        for (int ct = 0; ct < 2; ++ct)
#pragma unroll
            for (int r = 0; r < 4; ++r) uoff[ct][r] = (4 * q4) * 256 + ((((4 * wave + 2 * ct + (r16 >> 3)) ^ ((4 * q4 + r) & 15))) << 4) + 2 * (r16 & 7);
        LAS bf16* obase = (LAS bf16*)(lds + DNB_O) + (4 * q4) * OSTR + 32 * wave + r16;
        LDS_BARRIER();
        unsigned long long dnt_acc = 0, dnt_t0 = 0; (void)dnt_t0;
#pragma unroll 1
        for (int c = c0; c < c1; ++c) {
            const LAS unsigned char* bb = lds + (c & 1) * DNB_BYTES;
            if (PROBE_DNT == 3) dnt_t0 = __builtin_amdgcn_s_memtime();
            const float egl = ((const float*)(a.ws + DI_EGL))[bh * 32 + c];
            bf16x8v sb[2][4];
#pragma unroll
            for (int ct = 0; ct < 2; ++ct)
#pragma unroll
                for (int kk = 0; kk < 4; ++kk) sb[ct][kk] = pack8(S[ct][2 * kk], S[ct][2 * kk + 1]);
#define DN_SB() __builtin_amdgcn_sched_barrier(0)
            f32x4 vn[2][4];
#pragma unroll
            for (int hf = 0; hf < 2; ++hf) {
                bf16x8v fw[2][4]; float uv[2][8];
#pragma unroll
                for (int i = 0; i < 2; ++i) {
#pragma unroll
                    for (int kk = 0; kk < 4; ++kk) fw[i][kk] = *(const LAS bf16x8v*)(bb + DNB_W + (2 * hf + i) * 4096 + fA[kk]);
#pragma unroll
                    for (int ct = 0; ct < 2; ++ct)
#pragma unroll
                        for (int r = 0; r < 4; ++r) uv[ct][4 * i + r] = bf2f(*(const LAS bf16*)(lds + DNB_U + (2 * hf + i) * 4096 + r * 256 + uoff[ct][r])); }
#pragma unroll
                for (int ct = 0; ct < 2; ++ct) { vn[ct][2 * hf] = (f32x4){0.f, 0.f, 0.f, 0.f}; vn[ct][2 * hf + 1] = (f32x4){0.f, 0.f, 0.f, 0.f}; }
                DN_SB();
#pragma unroll
                for (int kk = 0; kk < 4; ++kk)
#pragma unroll
                    for (int i = 0; i < 2; ++i)
#pragma unroll
                        for (int ct = 0; ct < 2; ++ct) vn[ct][2 * hf + i] = __builtin_amdgcn_mfma_f32_16x16x32_bf16(fw[i][kk], sb[ct][kk], vn[ct][2 * hf + i], 0, 0, 0);
#pragma unroll
                for (int ct = 0; ct < 2; ++ct)
#pragma unroll
                    for (int i = 0; i < 2; ++i)
#pragma unroll
                        for (int r = 0; r < 4; ++r) vn[ct][2 * hf + i][r] = uv[ct][4 * i + r] - vn[ct][2 * hf + i][r];
            }
            bf16x8v vb[2][2];
#pragma unroll
            for (int ct = 0; ct < 2; ++ct) { vb[ct][0] = pack8(vn[ct][0], vn[ct][1]); vb[ct][1] = pack8(vn[ct][2], vn[ct][3]); }
            if (PROBE_DNT == 3) { asm volatile("s_waitcnt lgkmcnt(0)" ::: "memory"); dnt_acc += __builtin_amdgcn_s_memtime() - dnt_t0; }
            if (PROBE_DNT == 1) { asm volatile("s_waitcnt lgkmcnt(0)" ::: "memory"); dnt_t0 = __builtin_amdgcn_s_memtime(); __builtin_amdgcn_s_barrier(); dnt_acc += __builtin_amdgcn_s_memtime() - dnt_t0; asm volatile("" ::: "memory"); } else
            LDS_BARRIER();
#pragma unroll
            for (int hf = 0; hf < 2; ++hf) {
                f32x4 o[2][2];
                bf16x8v fq[2][4], fa[2][2];
#pragma unroll
                for (int i = 0; i < 2; ++i) {
#pragma unroll
                    for (int kk = 0; kk < 4; ++kk) fq[i][kk] = *(const LAS bf16x8v*)(bb + DNB_QG + (2 * hf + i) * 4096 + fA[kk]);
#pragma unroll
                    for (int k2 = 0; k2 < 2; ++k2) fa[i][k2] = *(const LAS bf16x8v*)(bb + DNB_ATT + (2 * hf + i) * 2048 + fB[k2]); }
#pragma unroll
                for (int ct = 0; ct < 2; ++ct) { o[ct][0] = (f32x4){0.f, 0.f, 0.f, 0.f}; o[ct][1] = (f32x4){0.f, 0.f, 0.f, 0.f}; }
                DN_SB();
#pragma unroll
                for (int kk = 0; kk < 4; ++kk)
#pragma unroll
                    for (int i = 0; i < 2; ++i)
#pragma unroll
                        for (int ct = 0; ct < 2; ++ct) o[ct][i] = __builtin_amdgcn_mfma_f32_16x16x32_bf16(fq[i][kk], sb[ct][kk], o[ct][i], 0, 0, 0);
#pragma unroll
                for (int k2 = 0; k2 < 2; ++k2)
#pragma unroll
                    for (int i = 0; i < 2; ++i)
#pragma unroll
                        for (int ct = 0; ct < 2; ++ct) o[ct][i] = __builtin_amdgcn_mfma_f32_16x16x32_bf16(fa[i][k2], vb[ct][k2], o[ct][i], 0, 0, 0);
#pragma unroll
                for (int ct = 0; ct < 2; ++ct)
#pragma unroll
                    for (int i = 0; i < 2; ++i)
#pragma unroll
                        for (int r = 0; r < 4; ++r) obase[(16 * (2 * hf + i) + r) * OSTR + 16 * ct] = (bf16)f2bf(o[ct][i][r]);
            }
#pragma unroll
            for (int ct = 0; ct < 2; ++ct)
#pragma unroll
                for (int j = 0; j < 8; ++j) S[ct][j] = S[ct][j] * egl;
#pragma unroll
            for (int hf = 0; hf < 2; ++hf) {
                bf16x8v fk[4][2];
#pragma unroll
                for (int j = 0; j < 4; ++j)
#pragma unroll
                    for (int k2 = 0; k2 < 2; ++k2) fk[j][k2] = *(const LAS bf16x8v*)(bb + DNB_KGT + (4 * hf + j) * 2048 + fB[k2]);
                DN_SB();
#pragma unroll
                for (int k2 = 0; k2 < 2; ++k2)
#pragma unroll
                    for (int j = 0; j < 4; ++j)
#pragma unroll
                        for (int ct = 0; ct < 2; ++ct) S[ct][4 * hf + j] = __builtin_amdgcn_mfma_f32_16x16x32_bf16(fk[j][k2], vb[ct][k2], S[ct][4 * hf + j], 0, 0, 0);
            }
#undef DN_SB
            if (PROBE_DNT == 2) { asm volatile("s_waitcnt lgkmcnt(0)" ::: "memory"); dnt_t0 = __builtin_amdgcn_s_memtime(); __builtin_amdgcn_s_barrier(); dnt_acc += __builtin_amdgcn_s_memtime() - dnt_t0; asm volatile("" ::: "memory"); } else
            LDS_BARRIER();
        }
        if (PROBE_DNT >= 1 && PROBE_DNT <= 3 && wave == 0) { const unsigned long long te = __builtin_amdgcn_s_memtime(); while (__builtin_amdgcn_s_memtime() - te < DNT_K * dnt_acc) __builtin_amdgcn_s_sleep(4); }
        if (c1 < 32) {
#pragma unroll
            for (int ct = 0; ct < 2; ++ct)
#pragma unroll
                for (int j = 0; j < 8; ++j) sst[256 * (8 * ct + j)] = S[ct][j];
        } else {
            float* So = a.out + OFF_DP + (((size_t)(l * NB + b) * DNH + h) << 14) + 32 * wave + r16;
#pragma unroll
            for (int ct = 0; ct < 2; ++ct)
#pragma unroll
                for (int j = 0; j < 8; ++j)
#pragma unroll
                    for (int r = 0; r < 4; ++r) So[(16 * j + 4 * q4 + r) * 128 + 16 * ct] = S[ct][j][r];
        }
        LDS_BARRIER();
    } else {
        const int et = tid - 256;
        int offA[4], offB[4];
#pragma unroll
        for (int n = 0; n < 4; ++n) { const int p = et + 256 * n; offA[n] = (p >> 4) * 256 + (((p & 15) ^ ((p >> 4) & 15)) << 4); offB[n] = (p >> 3) * 128 + (((p & 7) ^ ((p >> 4) & 7)) << 4); }
        v4u pw[4], pq[4], pk[4], pa[2], pu[4];
#define DN_ISSUE(cn) do { const size_t it_ = (size_t)(bh * 32 + (cn)); \
        const v4u* gw = (const v4u*)((const bf16*)(a.ws + DI_W) + it_ * 8192) + et; const v4u* gq = (const v4u*)((const bf16*)(a.ws + DI_QG) + it_ * 8192) + et; \
        const v4u* gk = (const v4u*)((const bf16*)(a.ws + DI_KGT) + it_ * 8192) + et; const v4u* ga = (const v4u*)((const bf16*)(a.ws + DI_ATT) + it_ * 4096) + et; \
        const v4u* gu = (const v4u*)((const bf16*)(a.ws + DI_U) + it_ * 8192) + et; \
        _Pragma("unroll") for (int n_ = 0; n_ < 4; ++n_) { pw[n_] = gw[256 * n_]; pq[n_] = gq[256 * n_]; pk[n_] = gk[256 * n_]; pu[n_] = gu[256 * n_]; } \
        pa[0] = ga[0]; pa[1] = ga[256]; } while (0)
#define DN_COMMIT_OPS(cn) do { LAS unsigned char* bb_ = lds + ((cn) & 1) * DNB_BYTES; \
        _Pragma("unroll") for (int n_ = 0; n_ < 4; ++n_) { *(LAS v4u*)(bb_ + DNB_W + offA[n_]) = pw[n_]; *(LAS v4u*)(bb_ + DNB_QG + offA[n_]) = pq[n_]; *(LAS v4u*)(bb_ + DNB_KGT + offB[n_]) = pk[n_]; } \
        *(LAS v4u*)(bb_ + DNB_ATT + offB[0]) = pa[0]; *(LAS v4u*)(bb_ + DNB_ATT + offB[1]) = pa[1]; } while (0)
#define DN_COMMIT_U() do { _Pragma("unroll") for (int n_ = 0; n_ < 4; ++n_) *(LAS v4u*)(lds + DNB_U + offA[n_]) = pu[n_]; } while (0)
        const int ew = wave - 4, trow = 16 * ew + (lane >> 2), cg = lane & 3;
        v4u zc[4];
        if (et < 32) { int e2 = et; asm volatile("" : "+v"(e2)); *(LAS f32x4*)(lds + DNB_NW + 16 * e2) = ((const f32x4*)(a.in[I_DNNW] + l * DHD))[e2]; }
#define DN_ZLOAD(cz) do { const v4u* zp = (const v4u*)(PROJ + (size_t)(b * SEQ + 64 * (cz) + trow) * NPROJ + 2560 + h * 128 + 32 * cg); \
        _Pragma("unroll") for (int k_ = 0; k_ < 4; ++k_) zc[k_] = zp[k_]; } while (0)
        DN_ISSUE(c0);
        DN_COMMIT_OPS(c0); DN_COMMIT_U();
        if (c0 + 1 < c1) DN_ISSUE(c0 + 1);
        DN_ZLOAD(c0);
        LDS_BARRIER();
#define DN_EPI_READ() v4u ov[4]; { const LAS v4u* op = (const LAS v4u*)((LAS bf16*)(lds + DNB_O) + trow * OSTR + 32 * cg); _Pragma("unroll") for (int k_ = 0; k_ < 4; ++k_) ov[k_] = op[k_]; }
#define DN_EPI_FINISH(cp) do { float ss_ = 0.f; \
        _Pragma("unroll") for (int k_ = 0; k_ < 4; ++k_) { const unsigned w4_[4] = {ov[k_].x, ov[k_].y, ov[k_].z, ov[k_].w}; \
            _Pragma("unroll") for (int e_ = 0; e_ < 4; ++e_) { const float o0_ = __builtin_bit_cast(float, w4_[e_] << 16), o1_ = __builtin_bit_cast(float, w4_[e_] & 0xffff0000u); ss_ += o0_ * o0_ + o1_ * o1_; } } \
        ss_ = DPP_ADD(ss_, 0xB1); ss_ = DPP_ADD(ss_, 0x4E); \
        const float rstd_ = __builtin_amdgcn_rsqf(ss_ * (1.0f / DHD) + EPS); \
        v4u* mp_ = (v4u*)(MIX + (size_t)(b * SEQ + 64 * (cp) + trow) * DM + 512 + h * 128 + 32 * cg); \
        const LAS f32x4* nwp_ = (const LAS f32x4*)(lds + DNB_NW) + 8 * cg; \
        _Pragma("unroll") for (int k_ = 0; k_ < 4; ++k_) { const unsigned w4_[4] = {ov[k_].x, ov[k_].y, ov[k_].z, ov[k_].w}; const unsigned z4_[4] = {zc[k_].x, zc[k_].y, zc[k_].z, zc[k_].w}; unsigned r4_[4]; \
            const f32x4 nwa_ = nwp_[2 * k_], nwb_ = nwp_[2 * k_ + 1]; const float nw8_[8] = {nwa_.x, nwa_.y, nwa_.z, nwa_.w, nwb_.x, nwb_.y, nwb_.z, nwb_.w}; \
            _Pragma("unroll") for (int e_ = 0; e_ < 4; ++e_) { const float z0_ = __builtin_bit_cast(float, z4_[e_] << 16), z1_ = __builtin_bit_cast(float, z4_[e_] & 0xffff0000u); \
                const float o0_ = __builtin_bit_cast(float, w4_[e_] << 16), o1_ = __builtin_bit_cast(float, w4_[e_] & 0xffff0000u); \
                r4_[e_] = cvtpk_s(o0_ * rstd_ * nw8_[2 * e_] * silu_fast(z0_), o1_ * rstd_ * nw8_[2 * e_ + 1] * silu_fast(z1_)); } \
            mp_[k_] = (v4u){r4_[0], r4_[1], r4_[2], r4_[3]}; } } while (0)
        unsigned long long dnt_acc = 0, dnt_t0 = 0; (void)dnt_t0;
#pragma unroll 1
        for (int c = c0; c < c1; ++c) {
            if (PROBE_DNT == 6) dnt_t0 = __builtin_amdgcn_s_memtime();
            if (c > c0) { DN_EPI_READ();
                if (c + 1 < c1) DN_COMMIT_OPS(c + 1);
                if (PROBE_DNT == 6) { asm volatile("s_waitcnt lgkmcnt(0)" ::: "memory"); dnt_acc += __builtin_amdgcn_s_memtime() - dnt_t0; }
                if (PROBE_DNT == 4) { asm volatile("s_waitcnt lgkmcnt(0)" ::: "memory"); dnt_t0 = __builtin_amdgcn_s_memtime(); __builtin_amdgcn_s_barrier(); dnt_acc += __builtin_amdgcn_s_memtime() - dnt_t0; asm volatile("" ::: "memory"); } else
                LDS_BARRIER();
                if (c + 1 < c1) DN_COMMIT_U();
                DN_EPI_FINISH(c - 1);
                asm volatile("" ::: "memory");
                DN_ZLOAD(c);
                if (c + 2 < c1) DN_ISSUE(c + 2);
            } else {
                if (c + 1 < c1) DN_COMMIT_OPS(c + 1);
                LDS_BARRIER();
                if (c + 1 < c1) DN_COMMIT_U();
                if (c + 2 < c1) DN_ISSUE(c + 2);
            }
            if (PROBE_DNT == 5) { asm volatile("s_waitcnt lgkmcnt(0)" ::: "memory"); dnt_t0 = __builtin_amdgcn_s_memtime(); __builtin_amdgcn_s_barrier(); dnt_acc += __builtin_amdgcn_s_memtime() - dnt_t0; asm volatile("" ::: "memory"); } else
            LDS_BARRIER();
        }
        { DN_EPI_READ(); DN_EPI_FINISH(c1 - 1); }
        if (PROBE_DNT >= 4 && wave == 4) { const unsigned long long te = __builtin_amdgcn_s_memtime(); while (__builtin_amdgcn_s_memtime() - te < DNT_K * dnt_acc) __builtin_amdgcn_s_sleep(4); }
        LDS_BARRIER();
#undef DN_ISSUE
#undef DN_COMMIT_OPS
#undef DN_COMMIT_U
#undef DN_ZLOAD
#undef DN_EPI_READ
#undef DN_EPI_FINISH
    }
}


constexpr size_t RG_SUMS = WS_XN + 9 * MiB;
constexpr size_t RG_AV = 353 * MiB, RG_BV = RG_AV + 32 * MiB;
constexpr int XSTR = 68;
constexpr int XBSTR = 72;
constexpr int PSTR = 64;
constexpr int RG_RAW = 0, RG_XS = 68608, RG_PA = RG_XS + 64 * XSTR * 4, RG_PX = RG_PA + 64 * PSTR * 4, RG_XB = RG_PX + 64 * PSTR * 4, RG_PP = RG_XB + 64 * XBSTR * 2, RG_HH = RG_PP + 2048, RG_HIN = RG_HH + 2048, RG_END = RG_HIN + 2048;
static_assert(RG_END <= LDSCTL_OFF, "RG tile LDS map");
template <bool FIN>
__device__ __forceinline__ void rg_tile(const Args& a, int l, int tile, LAS unsigned char* lds, int tid) {
    asm volatile("" : "+v"(tid));
    LAS bf16* raw = (LAS bf16*)(lds + RG_RAW);
    LAS float* xs = (LAS float*)(lds + RG_XS);
    LAS float* pa = (LAS float*)(lds + RG_PA);
    LAS float* px = (LAS float*)(lds + RG_PX);
    LAS bf16* xb = (LAS bf16*)(lds + RG_XB);
    LAS float* PP = (LAS float*)(lds + RG_PP);
    LAS float* HH = (LAS float*)(lds + RG_HH);
    LAS float* hin = (LAS float*)(lds + RG_HIN);
    const int lane = tid & 63, wave = __builtin_amdgcn_readfirstlane(tid >> 6), q4 = lane >> 4, r16 = lane & 15;
    const bool prompt = tile < NB * 32;
    const int b = tile >> 5, c = tile & 31, gsm = tile - NB * 32;
    const int mbase = prompt ? b * SEQ + 64 * c : MP + 64 * gsm;
    const bf16* PROJ = (const bf16*)(a.ws + WS_H);
    float* SUMS = (float*)(a.ws + RG_SUMS);
    const bool light = FIN && prompt;
    if (!light)
#pragma unroll
    for (int n = 0; n < 9; ++n) { const int p = tid + 512 * n; if (p < 67 * 64) { const int slot = p >> 6, pc = p & 63, m = mbase - 3 + slot;
        v4u v = (v4u){0u, 0u, 0u, 0u};
        if (slot >= 3 || (prompt && c > 0)) v = *(const v4u*)(PROJ + (size_t)m * NPROJ + 8 * pc);
        *(LAS v4u*)(raw + slot * 512 + 8 * pc) = v; } }
    if (FIN && prompt) {
        float Pv[31], Hv[31];
#pragma unroll
        for (int cc = 0; cc < 31; ++cc) { Pv[cc] = 1.f; Hv[cc] = 0.f; if (cc < c) { const float* sp = SUMS + (size_t)(b * 32 + cc) * 1024; Pv[cc] = sp[tid]; Hv[cc] = sp[512 + tid]; } }
        float hh = 0.f;
#pragma unroll
        for (int cc = 0; cc < 31; ++cc) hh = Pv[cc] * hh + Hv[cc];
        hin[tid] = hh;
    }
    float nbwf[16], nba = 0.f, nbx = 0.f, nlam = 0.f; f32x4 ncw[8], ncb[2];
#define RG_LOAD_HEAD(hh_) do { const int ch_ = (hh_) * 64 + lane; \
        const float* wm_ = a.in[(wave >> 2) ? I_RGWX : I_RGWA] + ((size_t)(l * 8 + (hh_)) * 64) * 64 + 16 * (wave & 3) + r16; \
        _Pragma("unroll") for (int kk_ = 0; kk_ < 2; ++kk_) _Pragma("unroll") for (int jj_ = 0; jj_ < 8; ++jj_) nbwf[8 * kk_ + jj_] = wm_[(32 * kk_ + 8 * q4 + jj_) * 64]; \
        nba = a.in[I_RGBA][l * RGW + ch_]; nbx = a.in[I_RGBX][l * RGW + ch_]; nlam = a.in[I_LAM][l * RGW + ch_]; \
        const int chb_ = (hh_) * 64 + 8 * (tid & 7); \
        _Pragma("unroll") for (int tap_ = 0; tap_ < 4; ++tap_) { const f32x4* wp_ = (const f32x4*)(a.in[I_CONVW] + ((size_t)l * 4 + tap_) * CONVCH + chb_); ncw[2 * tap_] = wp_[0]; ncw[2 * tap_ + 1] = wp_[1]; } \
        { const f32x4* bp_ = (const f32x4*)(a.in[I_CONVB] + l * RGW + chb_); ncb[0] = bp_[0]; ncb[1] = bp_[1]; } } while (0)
    if (!light) RG_LOAD_HEAD(0);
    LDS_BARRIER();
#pragma unroll 1
    for (int hd = 0; hd < 8; ++hd) {
        const int ch = hd * 64 + lane;
        float av[8], bv[8], P = 1.f, Hl = 0.f;
        float gv[8];
        if (FIN) {
#pragma unroll
            for (int t = 0; t < 8; ++t) gv[t] = bf2f(PROJ[(size_t)(mbase + 8 * wave + t) * NPROJ + 2048 + ch]);
        }
        if (light) {
            const float* ap = (const float*)(a.ws + RG_AV) + (size_t)(mbase + 8 * wave) * RGW + ch; const float* bp = (const float*)(a.ws + RG_BV) + (size_t)(mbase + 8 * wave) * RGW + ch;
#pragma unroll
            for (int t = 0; t < 8; ++t) { av[t] = ap[t * RGW]; bv[t] = bp[t * RGW]; }
#pragma unroll
            for (int t = 0; t < 8; ++t) { P *= av[t]; Hl = av[t] * Hl + bv[t]; }
        } else {
        float bwf[16];
#pragma unroll
        for (int x = 0; x < 16; ++x) bwf[x] = nbwf[x];
        const float ba = nba, bx = nbx, lam = nlam;
        f32x4 cwv[8], cbv[2];
#pragma unroll
        for (int x = 0; x < 8; ++x) cwv[x] = ncw[x];
        cbv[0] = ncb[0]; cbv[1] = ncb[1];
        if (hd + 1 < 8) RG_LOAD_HEAD(hd + 1);
        {
            const int i = tid >> 3, sub = tid & 7, chb = hd * 64 + 8 * sub;
            const int t = prompt ? 3 : (i & 7);
            float o[8];
            { const f32x4 b0 = cbv[0], b1 = cbv[1]; o[0] = b0.x; o[1] = b0.y; o[2] = b0.z; o[3] = b0.w; o[4] = b1.x; o[5] = b1.y; o[6] = b1.z; o[7] = b1.w; }
#pragma unroll
            for (int tap = 0; tap < 4; ++tap) {
                const int back = 3 - tap;
                const f32x4 w0 = cwv[2 * tap], w1 = cwv[2 * tap + 1];
                float xv[8];
                if (t - back >= 0) { const v4u x0 = *(const LAS v4u*)(raw + (3 + i - back) * 512 + chb);
                    xv[0] = __builtin_bit_cast(float, x0.x << 16); xv[1] = __builtin_bit_cast(float, x0.x & 0xffff0000u); xv[2] = __builtin_bit_cast(float, x0.y << 16); xv[3] = __builtin_bit_cast(float, x0.y & 0xffff0000u);
                    xv[4] = __builtin_bit_cast(float, x0.z << 16); xv[5] = __builtin_bit_cast(float, x0.z & 0xffff0000u); xv[6] = __builtin_bit_cast(float, x0.w << 16); xv[7] = __builtin_bit_cast(float, x0.w & 0xffff0000u); }
                else { const f32x4* sp = (const f32x4*)(a.in[I_SCONV] + ((size_t)(l * NDB + 8 * gsm + (i >> 3)) * 3 + (3 + t - back)) * CONVCH + chb);
                    const f32x4 s0 = sp[0], s1 = sp[1]; xv[0] = s0.x; xv[1] = s0.y; xv[2] = s0.z; xv[3] = s0.w; xv[4] = s1.x; xv[5] = s1.y; xv[6] = s1.z; xv[7] = s1.w; }
                o[0] += w0.x * xv[0]; o[1] += w0.y * xv[1]; o[2] += w0.z * xv[2]; o[3] += w0.w * xv[3];
                o[4] += w1.x * xv[4]; o[5] += w1.y * xv[5]; o[6] += w1.z * xv[6]; o[7] += w1.w * xv[7];
            }
            LAS float* dst = xs + i * XSTR + 8 * sub;
            *(LAS f32x4*)dst = (f32x4){o[0], o[1], o[2], o[3]}; *(LAS f32x4*)(dst + 4) = (f32x4){o[4], o[5], o[6], o[7]};
            v4u ob; ob.x = cvtpk_s(o[0], o[1]); ob.y = cvtpk_s(o[2], o[3]); ob.z = cvtpk_s(o[4], o[5]); ob.w = cvtpk_s(o[6], o[7]);
            *(LAS v4u*)(xb + i * XBSTR + 8 * sub) = ob;
        }
        LDS_BARRIER();
        {
            bf16x8v bw[2];
            bw[0] = pack8((f32x4){bwf[0], bwf[1], bwf[2], bwf[3]}, (f32x4){bwf[4], bwf[5], bwf[6], bwf[7]});
            bw[1] = pack8((f32x4){bwf[8], bwf[9], bwf[10], bwf[11]}, (f32x4){bwf[12], bwf[13], bwf[14], bwf[15]});
            LAS float* outp = ((wave >> 2) ? px : pa) + 16 * (wave & 3) + r16;
            bf16x8v af[4][2];
#pragma unroll
            for (int ti = 0; ti < 4; ++ti)
#pragma unroll
                for (int kk = 0; kk < 2; ++kk) af[ti][kk] = *(const LAS bf16x8v*)(xb + (16 * ti + r16) * XBSTR + 32 * kk + 8 * q4);
#pragma unroll
            for (int ti = 0; ti < 4; ++ti) {
                f32x4 acc = (f32x4){0.f, 0.f, 0.f, 0.f};
                acc = __builtin_amdgcn_mfma_f32_16x16x32_bf16(af[ti][0], bw[0], acc, 0, 0, 0);
                acc = __builtin_amdgcn_mfma_f32_16x16x32_bf16(af[ti][1], bw[1], acc, 0, 0, 0);
#pragma unroll
                for (int r = 0; r < 4; ++r) outp[(16 * ti + 4 * q4 + r) * PSTR] = acc[r];
            }
        }
        LDS_BARRIER();
        const float spl = softplus_f(-lam);
#pragma unroll
        for (int t = 0; t < 8; ++t) { const int i = 8 * wave + t;
            const float r = sigmoid_f(pa[i * PSTR + lane] + ba), ig = sigmoid_f(px[i * PSTR + lane] + bx), la = -8.0f * r * spl;
            av[t] = __builtin_amdgcn_exp2f(1.44269504089f * la); bv[t] = __builtin_amdgcn_sqrtf(neg_expm1_f(2.0f * la)) * (ig * xs[i * XSTR + lane]);
            P *= av[t]; Hl = av[t] * Hl + bv[t]; }
        if (!FIN) {
            float* ap = (float*)(a.ws + RG_AV) + (size_t)(mbase + 8 * wave) * RGW + ch; float* bp = (float*)(a.ws + RG_BV) + (size_t)(mbase + 8 * wave) * RGW + ch;
#pragma unroll
            for (int t = 0; t < 8; ++t) { ap[t * RGW] = av[t]; bp[t * RGW] = bv[t]; }
        }
        }
        float hh;
        if (prompt) {
            PP[wave * 64 + lane] = P; HH[wave * 64 + lane] = Hl;
            LDS_BARRIER();
            hh = FIN ? hin[ch] : 0.f;
            for (int g = 0; g < wave; ++g) hh = PP[g * 64 + lane] * hh + HH[g * 64 + lane];
            if (!FIN && wave == 7) {
                float pt = P;
#pragma unroll
                for (int g = 0; g < 7; ++g) pt *= PP[g * 64 + lane];
                float* sp = SUMS + (size_t)tile * 1024; sp[ch] = pt; sp[512 + ch] = P * hh + Hl;
            }
        } else hh = a.in[I_SRG][(size_t)(l * NDB + 8 * gsm + wave) * RGW + ch];
        if (FIN) {
            bf16* MIX = (bf16*)(a.ws + WS_MIX);
#pragma unroll
            for (int t = 0; t < 8; ++t) { const size_t m = (size_t)(mbase + 8 * wave + t);
                hh = av[t] * hh + bv[t];
                MIX[m * DM + ch] = (bf16)f2bf(hh * gelu_tanh_f(gv[t])); }
            if (prompt) { if (c == 31 && wave == 7) a.out[OFF_RP + (size_t)(l * NB + b) * RGW + ch] = hh; }
            else a.out[OFF_RS + (size_t)(l * NDB + 8 * gsm + wave) * RGW + ch] = hh;
        }
        LDS_BARRIER();
    }
#undef RG_LOAD_HEAD
}


constexpr int NSCAN = NB * DNH;
constexpr int CSPLIT = 16;
__device__ __forceinline__ void prepa_newconv(const Args& a, int l, int tid) {
    const bf16* PROJ = (const bf16*)(a.ws + WS_H);
    for (int idx = blockIdx.x * (NWAVES * 64) + tid; idx < (NB + NDB) * 3 * CONVCH; idx += gridDim.x * NWAVES * 64) {
        const int c = idx & (CONVCH - 1), jr = (idx >> 11) % 3, sq = idx / (3 * CONVCH);
        if (sq < NB) a.out[OFF_CP + ((size_t)(l * NB + sq) * 3 + jr) * CONVCH + c] = bf2f(PROJ[(size_t)(sq * SEQ + SEQ - 3 + jr) * NPROJ + c]);
        else { const int bs = sq - NB; a.out[OFF_CS + ((size_t)(l * NDB + bs) * 3 + jr) * CONVCH + c] = bf2f(PROJ[(size_t)(MP + bs * DSEQ + DSEQ - 3 + jr) * NPROJ + c]); }
    }
}
__device__ __forceinline__ void prepa_phase(const Args& a, int l, int qid, LAS unsigned char* lds, volatile LAS unsigned* MISC, int tid0) {
    gu32* ctr = (gu32*)(a.ws + WS_CTL) + CW_QUEUE + 64 * qid;
    for (;;) {
        int tid = tid0; asm volatile("" : "+v"(tid));
        const int j = queue_next(ctr, MISC + 16, tid);
        if (j >= NSCAN * CSPLIT) break;
        dnprep_item(a, l, (j / CSPLIT) * 32 + (j % CSPLIT), lds, tid);
    }
    int tid = tid0; asm volatile("" : "+v"(tid));
    prepa_newconv(a, l, tid);
}
__device__ __forceinline__ void mid_phase(const Args& a, int l, int qid, LAS unsigned char* lds, volatile LAS unsigned* MISC, int tid0) {
    if ((int)blockIdx.x < NSCAN || (int)gridDim.x <= NSCAN) {
        int tid = tid0; asm volatile("" : "+v"(tid));
        for (int rp = 0; rp < PROBE_SFA; ++rp) for (int it = blockIdx.x; it < NSCAN; it += gridDim.x) dnscan_wg(a, l, it, 0, CSPLIT, lds, tid);
    }
    gu32* ctr = (gu32*)(a.ws + WS_CTL) + CW_QUEUE + 64 * qid;
    constexpr int NRG = NB * 32, NDN = NSCAN * (32 - CSPLIT);
    for (;;) {
        int tid = tid0; asm volatile("" : "+v"(tid));
        const int it = queue_next(ctr, MISC + 16, tid);
        if (it >= NRG + NDN) break;
        if (it < NRG) rg_tile<false>(a, l, it, lds, tid);
        else { const int j = it - NRG; dnprep_item(a, l, (j / (32 - CSPLIT)) * 32 + CSPLIT + (j % (32 - CSPLIT)), lds, tid); }
    }
}
__device__ __forceinline__ void fin_phase(const Args& a, int l, int qid, LAS unsigned char* lds, volatile LAS unsigned* MISC, int tid0) {
    if ((int)blockIdx.x < NSCAN || (int)gridDim.x <= NSCAN) {
        int tid = tid0; asm volatile("" : "+v"(tid));
        for (int rp = 0; rp < PROBE_SFA; ++rp) for (int it = blockIdx.x; it < NSCAN; it += gridDim.x) dnscan_wg(a, l, it, CSPLIT, 32, lds, tid);
    }
    gu32* ctr = (gu32*)(a.ws + WS_CTL) + CW_QUEUE + 64 * qid;
    constexpr int NRG = NB * 32 + NDB / 8, NDL = 2 * NDB;
    for (;;) {
        int tid = tid0; asm volatile("" : "+v"(tid));
        const int it = queue_next(ctr, MISC + 16, tid);
        const int NCV = l == 0 ? (WI_3 - WI_2 + NWAVES - 1) / NWAVES : 0;
        if (it >= NRG + NDL + NCV) break;
        if (it < NRG) rg_tile<true>(a, l, it, lds, tid);
        else if (it < NRG + NDL) delta_seq(a, l, it - NRG, lds, tid);
        else { const int w0 = WI_2 + (it - NRG - NDL) * NWAVES, wv = __builtin_amdgcn_readfirstlane(tid >> 6);
            wcvt_range(a, 0, w0 + wv, (w0 + NWAVES < WI_3 ? w0 + NWAVES : WI_3), 0, NWAVES, lds, wv, tid & 63);
            __syncthreads(); }
    }
}

constexpr int PH_PER_LAYER = 13, N_PHASES = DEPTH * PH_PER_LAYER;
enum { Q_WCVT = 0, Q_UP1, Q_DN1, Q_NORM1, Q_WIN, Q_PREPA, Q_MID, Q_FIN, Q_WOUT, Q_NORM2, Q_UP2, Q_DN2, Q_NORM3 };
__global__ void __launch_bounds__(NWAVES * 64, 2) fwd_kernel(Args a0) {
    extern __shared__ __attribute__((aligned(16))) unsigned char lds_raw[];
    LAS unsigned char* lds = (LAS unsigned char*)lds_raw;
    volatile LAS unsigned* MISC = (volatile LAS unsigned*)(lds + MISC_OFF);
    const int tid0 = threadIdx.x;
    for (int u = tid0; u < (LDS_BYTES - LDSCTL_OFF) / 4; u += NWAVES * 64) ((LAS unsigned*)(lds + LDSCTL_OFF))[u] = 0u;
    __syncthreads();
    const int lo = a0.ph_lo, hi = a0.ph_hi;
    gu32* ctl = (gu32*)(a0.ws + WS_CTL);
    typedef const __attribute__((address_space(4))) Args* CArgsP;
    CArgsP ap = (CArgsP)__builtin_amdgcn_kernarg_segment_ptr();
    XcdBarrier bar; bar.bar = (unsigned*)(ctl + CW_BAR); bar.x = 0; bar.st = nullptr;
    if (hi - lo > 1) bar = xcd_barrier_post((unsigned*)(ctl + CW_BAR), MISC + 8);
    const int hie = hi + (PROBE_Q >= 0 ? PROBE_REPS - 1 : 0);
    for (int st = lo; st < hie; ++st) {
        const int pi = (PROBE_Q >= 0 && st > PROBE_Q) ? (st - PROBE_Q < PROBE_REPS ? PROBE_Q : st - (PROBE_REPS - 1)) : st;
        asm volatile("" : "+s"(ap));
        const Args& a = *(const Args*)ap;
        int tid = tid0; asm volatile("" : "+v"(tid));
        const int lane = tid & 63, wave = __builtin_amdgcn_readfirstlane(tid >> 6);
        const int l = pi / PH_PER_LAYER, q = pi - l * PH_PER_LAYER;
        if (l == 1 && q == Q_WCVT && lo < pi) continue;

        if (q == Q_UP1 || q == Q_DN1 || q == Q_WIN || q == Q_WOUT || q == Q_UP2 || q == Q_DN2) {
#if EN_GEMM
            const bool isup = (q == Q_UP1 || q == Q_UP2), isdn = (q == Q_DN1 || q == Q_DN2);
            const bf16* A = (isup || q == Q_WIN) ? (const bf16*)(a.ws + WS_XN) : (isdn ? (const bf16*)(a.ws + WS_H) : (const bf16*)(a.ws + WS_MIX));
            const size_t wo = q == Q_UP1 ? WO_UP1 : q == Q_DN1 ? WO_DN1 : q == Q_WIN ? WO_WIN : q == Q_WOUT ? WO_WOUT : q == Q_UP2 ? WO_UP2 : WO_DN2;
            const int N = isup ? 2 * DFF : (q == Q_WIN ? NPROJ : DM), K = isdn ? DFF : DM;
            pg8::Gemm g{A, (const bf16*)(a.ws + WS_W + wo), M, N, K};
            const bool isd = !(isup || q == Q_WIN);
            const int nsp = isd ? (isdn ? NSPLIT_DN : NSPLIT_OUT) : 1;
            pg8::SplitOrder S; S.init(isd ? MP : M, isd ? MS : 0, N, K, nsp, gridDim.x, (int)blockIdx.x);
            pg8::EpiAny E{isup ? 0 : 1, isd ? (bf16*)(a.ws + WS_D) : (bf16*)(a.ws + WS_H), isup ? DFF : (isd ? DM : NPROJ), isd ? MP / 256 : M / 256, (bf16*)(a.ws + WS_DSLAB)};
            pg8::gemm_phase<pg8::EpiAny, pg8::SplitOrder, true, true>(lds, g, S, E);
#if EN_WCVT
            {
                const int nun = isd ? (MP / 256) * (N / 256) + (MS / 256) * (N / 256) * nsp : (M / 256) * (N / 256);
                const int nrem = nun % (int)gridDim.x, nidle = nrem ? (int)gridDim.x - nrem : (int)gridDim.x, me = nrem ? (int)blockIdx.x - nrem : (int)blockIdx.x;
                int lo_ = 0, hi_ = 0, lw = l;
                if (l == 0 && q == Q_WIN) { lo_ = WI_0; hi_ = WI_1; lw = 1; } else if (l == 0 && q == Q_UP2) { lo_ = WI_1; hi_ = WI_2; lw = 1; } else if (l == 1 && q == Q_WIN) { lo_ = WI_2; hi_ = WI_3; }
                if (hi_ > lo_ && me >= 0) wcvt_range(a, lw, lo_, hi_, me * NWAVES + wave, nidle * NWAVES, lds, wave, lane);
                __syncthreads();
            }
#endif
#endif
#if EN_SCAL
            if (q == Q_WIN) for (int rs = 0; rs < PROBE_SCAL; ++rs) scal_phase(a, l, lds, tid, wave, lane);
#endif
        } else if (q == Q_WCVT) {
#if EN_WCVT
            if (l == 0) { wcvt_range(a, 0, WI_0, WI_2, blockIdx.x * NWAVES + wave, gridDim.x * NWAVES, lds, wave, lane); xn0_phase(a, wave, lane); }
#endif
        } else if (q == Q_PREPA) {
#if EN_PREP
            prepa_phase(a, l, st, lds, MISC, tid);
#endif
        } else if (q == Q_MID) {
#if EN_PREP
            mid_phase(a, l, st, lds, MISC, tid);
#endif
        } else if (q == Q_FIN) {
#if EN_SCANFIN
            fin_phase(a, l, st, lds, MISC, tid);
#endif
        } else {
#if EN_NORM
            const int s = q == Q_NORM1 ? 0 : (q == Q_NORM2 ? 1 : 2);
            const float* gpost = a.in[s == 0 ? I_F1POST : (s == 1 ? I_MPOST : I_F2POST)] + l * DM;
            const float* gnext = s == 0 ? a.in[I_MPRE] + l * DM : (s == 1 ? a.in[I_F2PRE] + l * DM : (l + 1 < DEPTH ? a.in[I_F1PRE] + (l + 1) * DM : a.in[I_FINAL]));
            norm_phase(a, gpost, gnext, s == 1 ? 1.0f : 0.5f, 3 * l + s, pi == N_PHASES - 1, s == 1 ? NSPLIT_OUT : NSPLIT_DN, wave, lane);
#endif
        }
        if (st + 1 < hie) for (int pb = 0; pb < PROBE_BAR; ++pb) xcd_barrier(bar);
    }
}

extern "C" void kernel_launch(void* const* d_in, const int* in_sizes, int n_in, void* d_out, int out_size, void* d_ws, size_t ws_size, hipStream_t stream) {
    static int grid = 0;
    if (grid == 0) {
        if (n_in != N_IN || out_size != (int)OUT_TOTAL || ws_size < WS_END) { fprintf(stderr, "kernel_launch: unexpected shapes (n_in %d, out %d, ws %zu); nothing launched\n", n_in, out_size, ws_size); grid = -1; return; }
        int dev = 0, cus = 0;
        if (hipGetDevice(&dev) != hipSuccess || hipDeviceGetAttribute(&cus, hipDeviceAttributeMultiprocessorCount, dev) != hipSuccess) { grid = -1; return; }
        if (hipFuncSetAttribute((const void*)fwd_kernel, hipFuncAttributeMaxDynamicSharedMemorySize, LDS_BYTES) != hipSuccess) { fprintf(stderr, "kernel_launch: hipFuncSetAttribute failed\n"); grid = -1; return; }
        (void)hipGetLastError();
        grid = cus;
    }
    if (grid < 0) return;
    if (hipMemsetAsync((char*)d_ws + WS_CTL, 0, CTL_ZERO_BYTES, stream) != hipSuccess) return;
    Args a{};
    for (int i = 0; i < N_IN; ++i) a.in[i] = (const float*)d_in[i];
    a.out = (float*)d_out; a.ws = (unsigned char*)d_ws;
#if MK_SINGLE
    a.ph_lo = 0; a.ph_hi = N_PHASES;
    hipLaunchKernelGGL(fwd_kernel, dim3(grid), dim3(NWAVES * 64), LDS_BYTES, stream, a);
#else
    for (int p = 0; p < N_PHASES; ++p) { a.ph_lo = p; a.ph_hi = p + 1; hipLaunchKernelGGL(fwd_kernel, dim3(grid), dim3(NWAVES * 64), LDS_BYTES, stream, a); }
#endif
}
```

```cpp
#include <hip/hip_runtime.h>
#include <cstdio>
#include <cstdint>
namespace pg8 {
#define PG8_LAS __attribute__((address_space(3)))
typedef unsigned short bf16_t;
typedef short bf16x8 __attribute__((ext_vector_type(8)));
typedef float f32x4 __attribute__((ext_vector_type(4)));
typedef unsigned u32x4 __attribute__((ext_vector_type(4)));
constexpr int BM = 256, BK = 64, HALF = 128, HTB = HALF * BK * 2  , STAGE_BYTES = 8 * HTB, NXCD = 8, WGM = 8;

__host__ __device__ __forceinline__ int lds_byte(int r, int c) { const int st = (r >> 4) * 2 + (c >> 5), rr = r & 15, cc = c & 31, ob = rr * 64 + cc * 2; return st * 1024 + (ob ^ (((ob >> 9) & 1) << 5)); }
__host__ __device__ __forceinline__ void stage_rc(int b, int& R, int& C) { const int st = b / 1024, sb = b % 1024, swz = sb ^ (((sb >> 9) & 1) << 5); R = (st >> 1) * 16 + swz / 64; C = (st & 1) * 32 + (swz % 64) / 2; }
__host__ __device__ __forceinline__ int perm32(int rho) { const int n = rho >> 4, i = rho & 15; return 8 * (i >> 2) + 4 * n + (i & 3); }

struct Unit { int pm, pn, kt0, nt, ks; };
struct Gemm { const bf16_t* A; const bf16_t* Bt; int M, N, K; };

struct StaticOrder {
    int nM, nN, nwg, G, c, ntf;
    __host__ __device__ void init(int M, int N, int G_, int c_) { nM = M / BM; nN = N / BM; nwg = nM * nN; G = G_; c = c_; }
    __host__ __device__ __forceinline__ bool next(int i, Unit& u) const {
        const long L = (long)i * G + c; if (L >= nwg) return false;
        int wgid = (int)L; { const int q = nwg / NXCD, r = nwg % NXCD, xcd = wgid % NXCD, off = wgid / NXCD; wgid = (xcd < r ? xcd * (q + 1) : r * (q + 1) + (xcd - r) * q) + off; }
        const int nig = WGM * nN, gid = wgid / nig, fm = gid * WGM, gsz = (nM - fm) < WGM ? (nM - fm) : WGM;
        u.pm = fm + ((wgid % nig) % gsz); u.pn = (wgid % nig) / gsz; u.kt0 = 0; u.nt = ntf; u.ks = 0; return true;
    }
    __device__ __forceinline__ void a_ready(const Unit&) const {}
    __device__ __forceinline__ void done(const Unit&) const {}
};
struct SplitOrder {
    StaticOrder full; int mfull, mrest, nN, nsplit, nts, nfull;
    __host__ __device__ void init(int Mfull, int Mrest, int N, int K, int nsplit_, int G_, int c_) { full.init(Mfull, N, G_, c_); full.ntf = K / BK; mfull = Mfull / BM; mrest = Mrest / BM; nN = N / BM; nsplit = nsplit_; nts = K / BK / nsplit_; nfull = full.nwg; }
    __host__ __device__ __forceinline__ bool next(int i, Unit& u) const {
        const int L = i * full.G + full.c;
        const int j = L - nfull, nrest = mrest * nN * nsplit;
        if (j >= nrest) return false;
        Unit f; f.pm = 0; f.pn = 0; f.kt0 = 0; f.nt = 0; f.ks = 0;
        if (j < 0) (void)full.next(i, f);
        const int jj = j < 0 ? 0 : j, ks = jj % nsplit, q = jj / nsplit;
        const bool isfull = j < 0;
        u.pm = isfull ? f.pm : mfull + q / nN; u.pn = isfull ? f.pn : q % nN; u.ks = isfull ? 0 : ks; u.kt0 = isfull ? 0 : ks * nts; u.nt = isfull ? full.ntf : nts;
        return true;
    }
    __device__ __forceinline__ void a_ready(const Unit&) const {}
    __device__ __forceinline__ void done(const Unit&) const {}
};


__device__ __forceinline__ unsigned cvt_pk_bf16(float lo, float hi) { unsigned r; asm volatile("v_cvt_pk_bf16_f32 %0, %1, %2" : "=v"(r) : "v"(lo), "v"(hi)); return r; }
typedef float f32x2 __attribute__((ext_vector_type(2)));
struct EpiF32 {
    static constexpr bool PERM = false, AFTER_DRAIN = false;
    float* C; int ldc;
    __device__ __forceinline__ void operator()(const f32x4 (&acc)[2][2][4][2], const Unit& u, int wr, int wc, int fr, int fq) const {
        const int row0 = u.pm * BM + wr * 64 + fr, col0 = u.pn * BM + wc * 32 + 4 * fq;
#pragma unroll
        for (int ai = 0; ai < 2; ++ai)
#pragma unroll
            for (int m = 0; m < 4; ++m) { float* rowp = C + (size_t)(row0 + ai * HALF + m * 16) * ldc + col0;
#pragma unroll
                for (int bj = 0; bj < 2; ++bj)
#pragma unroll
                    for (int n = 0; n < 2; ++n) *(f32x4*)(rowp + bj * HALF + n * 16) = acc[ai][bj][m][n]; }
    }
};
struct EpiBf16 {
    static constexpr bool PERM = true, AFTER_DRAIN = false;
    bf16_t* O; int ldc;
    __device__ __forceinline__ void operator()(const f32x4 (&acc)[2][2][4][2], const Unit& u, int wr, int wc, int fr, int fq) const {
        const int row0 = u.pm * BM + wr * 64 + fr, col0 = u.pn * BM + wc * 32 + 8 * fq;
#pragma unroll
        for (int ai = 0; ai < 2; ++ai)
#pragma unroll
            for (int m = 0; m < 4; ++m) { bf16_t* rowp = O + (size_t)(row0 + ai * HALF + m * 16) * ldc + col0;
#pragma unroll
                for (int bj = 0; bj < 2; ++bj) { const f32x4 v0 = acc[ai][bj][m][0], v1 = acc[ai][bj][m][1];
                    u32x4 w; w.x = cvt_pk_bf16(v0[0], v0[1]); w.y = cvt_pk_bf16(v0[2], v0[3]); w.z = cvt_pk_bf16(v1[0], v1[1]); w.w = cvt_pk_bf16(v1[2], v1[3]);
                    *(u32x4*)(rowp + bj * HALF) = w; } }
    }
};
__device__ __forceinline__ float silu_f(float x) { return x * __builtin_amdgcn_rcpf(1.0f + __builtin_amdgcn_exp2f(-1.44269504089f * x)); }
struct EpiSwiGLU {
    static constexpr bool PERM = true, AFTER_DRAIN = false;
    bf16_t* O; int ldc;
    __device__ __forceinline__ void operator()(const f32x4 (&acc)[2][2][4][2], const Unit& u, int wr, int wc, int fr, int fq) const {
        const int row0 = u.pm * BM + wr * 64 + fr, col0 = u.pn * HALF + wc * 32 + 8 * fq;
#pragma unroll
        for (int ai = 0; ai < 2; ++ai)
#pragma unroll
            for (int m = 0; m < 4; ++m) { bf16_t* rowp = O + (size_t)(row0 + ai * HALF + m * 16) * ldc + col0;
                const f32x4 g0 = acc[ai][0][m][0], g1 = acc[ai][0][m][1], u0 = acc[ai][1][m][0], u1 = acc[ai][1][m][1];
                u32x4 w;
                w.x = cvt_pk_bf16(silu_f(g0[0]) * u0[0], silu_f(g0[1]) * u0[1]); w.y = cvt_pk_bf16(silu_f(g0[2]) * u0[2], silu_f(g0[3]) * u0[3]);
                w.z = cvt_pk_bf16(silu_f(g1[0]) * u1[0], silu_f(g1[1]) * u1[1]); w.w = cvt_pk_bf16(silu_f(g1[2]) * u1[2], silu_f(g1[3]) * u1[3]);
                *(u32x4*)rowp = w; }
    }
};

constexpr int M_ROWS = 17408;
struct EpiAny {
    static constexpr bool PERM = true, AFTER_DRAIN = false;
    int mode; bf16_t* O; int ldo; int mfull; bf16_t* Oslab;
    __device__ __forceinline__ void operator()(const f32x4 (&acc)[2][2][4][2], const Unit& u, int wr, int wc, int fr, int fq) const {
        const int row0 = u.pm * BM + wr * 64 + fr;
        if (mode == 0) {
            const int col0 = u.pn * HALF + wc * 32 + 8 * fq;
#pragma unroll
            for (int ai = 0; ai < 2; ++ai)
#pragma unroll
                for (int m = 0; m < 4; ++m) { bf16_t* rowp = O + (size_t)(row0 + ai * HALF + m * 16) * ldo + col0;
                    const f32x4 g0 = acc[ai][0][m][0], g1 = acc[ai][0][m][1], u0 = acc[ai][1][m][0], u1 = acc[ai][1][m][1];
                    u32x4 w;
                    w.x = cvt_pk_bf16(silu_f(g0[0]) * u0[0], silu_f(g0[1]) * u0[1]); w.y = cvt_pk_bf16(silu_f(g0[2]) * u0[2], silu_f(g0[3]) * u0[3]);
                    w.z = cvt_pk_bf16(silu_f(g1[0]) * u1[0], silu_f(g1[1]) * u1[1]); w.w = cvt_pk_bf16(silu_f(g1[2]) * u1[2], silu_f(g1[3]) * u1[3]);
                    *(u32x4*)rowp = w; }
        } else {
            const int col0 = u.pn * BM + wc * 32 + 8 * fq;
            bf16_t* Ob = u.pm < mfull ? O : Oslab + (size_t)u.ks * ((size_t)(M_ROWS - mfull * BM) * ldo) - (size_t)(mfull * BM) * ldo;
#pragma unroll
            for (int ai = 0; ai < 2; ++ai)
#pragma unroll
                for (int m = 0; m < 4; ++m) { bf16_t* rowp = Ob + (size_t)(row0 + ai * HALF + m * 16) * ldo + col0;
#pragma unroll
                    for (int bj = 0; bj < 2; ++bj) { const f32x4 v0 = acc[ai][bj][m][0], v1 = acc[ai][bj][m][1];
                        u32x4 w; w.x = cvt_pk_bf16(v0[0], v0[1]); w.y = cvt_pk_bf16(v0[2], v0[3]); w.z = cvt_pk_bf16(v1[0], v1[1]); w.w = cvt_pk_bf16(v1[2], v1[3]);
                        *(u32x4*)(rowp + bj * HALF) = w; } }
        }
    }
};
template <class Epi, class Sched, bool ALIGN_EPI = false, bool SP2 = false>
__device__ __forceinline__ void gemm_phase(PG8_LAS unsigned char* lds, const Gemm g, const Sched& S, const Epi& E) {
    int tid_l = threadIdx.x; asm volatile("" : "+v"(tid_l));
    const int tid = tid_l, wid = __builtin_amdgcn_readfirstlane(tid >> 6), lane = tid & 63, wr = wid >> 2, wc = wid & 3, fr = lane & 15, fq = lane >> 4;
    const int K = g.K;
    unsigned voffA[2], voffB[2];
#pragma unroll
    for (int i = 0; i < 2; ++i) { int R, C; stage_rc(tid * 16 + i * 8192, R, C); const int Rb = Epi::PERM ? ((R & ~31) + perm32(R & 31)) : R;
        voffA[i] = (unsigned)(R * K + C) * 2u; voffB[i] = (unsigned)(Rb * K + C) * 2u; }
    const size_t kstep = (size_t)(BK * 2);
    const size_t hstep = (size_t)HALF * K * 2;
    const size_t tstep = 2 * hstep;
    const unsigned ldsw = (unsigned)wid * 1024u;
    const int aoff = lds_byte(wr * 64 + fr, fq * 8), boff = lds_byte(wc * 32 + fr, fq * 8);
#define PG8_SA(b, h) (((b) * 2 + (h)) * HTB)
#define PG8_SB(b, h) ((4 + (b) * 2 + (h)) * HTB)
#define PG8_STAGE(bufoff, gbase, voff) do { _Pragma("unroll") for (int _i = 0; _i < 2; ++_i) \
        __builtin_amdgcn_global_load_lds((const unsigned*)((const char*)(gbase) + (voff)[_i]), (PG8_LAS unsigned*)(lds + (bufoff) + ldsw + _i * 8192), 16, 0, 0); } while (0)
#define PG8_LDA(dst, b, h) do { _Pragma("unroll") for (int m = 0; m < 4; ++m) _Pragma("unroll") for (int k = 0; k < 2; ++k) dst[m][k] = *(const PG8_LAS bf16x8*)(lds + PG8_SA(b, h) + aoff + m * 2048 + k * 1024); } while (0)
#define PG8_LDB(dst, b, h) do { _Pragma("unroll") for (int n = 0; n < 2; ++n) _Pragma("unroll") for (int k = 0; k < 2; ++k) dst[n][k] = *(const PG8_LAS bf16x8*)(lds + PG8_SB(b, h) + boff + n * 2048 + k * 1024); } while (0)
#define PG8_MMA(ai, bj, At, Bt) do { __builtin_amdgcn_s_setprio(1); _Pragma("unroll") for (int m = 0; m < 4; ++m) _Pragma("unroll") for (int n = 0; n < 2; ++n) _Pragma("unroll") for (int k = 0; k < 2; ++k) \
        acc[ai][bj][m][n] = __builtin_amdgcn_mfma_f32_16x16x32_bf16(Bt[n][k], At[m][k], acc[ai][bj][m][n], 0, 0, 0); __builtin_amdgcn_s_setprio(0); } while (0)
#define PG8_WAIT_V(n) asm volatile("s_waitcnt vmcnt(" #n ")" ::: "memory")
#define PG8_WAIT_L(n) asm volatile("s_waitcnt lgkmcnt(" #n ")" ::: "memory")
#define PG8_BAR __builtin_amdgcn_s_barrier()
#define PG8_SCHED __builtin_amdgcn_sched_barrier(0)
    Unit cur, nxt; int ui = 0;
    if (!S.next(0, cur)) return;
    f32x4 acc[2][2][4][2];
#pragma unroll
    for (int a = 0; a < 2; ++a)
#pragma unroll
        for (int b = 0; b < 2; ++b)
#pragma unroll
            for (int m = 0; m < 4; ++m)
#pragma unroll
                for (int n = 0; n < 2; ++n) acc[a][b][m][n] = (f32x4){0.f, 0.f, 0.f, 0.f};
    bf16x8 At[4][2], B0[2][2], B1[2][2];
    const char* cA = (const char*)g.A + (size_t)cur.pm * tstep + (size_t)cur.kt0 * (BK * 2); const char* cB = (const char*)g.Bt + (size_t)cur.pn * tstep + (size_t)cur.kt0 * (BK * 2);
    S.a_ready(cur);
    if constexpr (SP2) {
        PG8_STAGE(PG8_SB(0, 0), cB, voffB); PG8_STAGE(PG8_SB(0, 1), cB + hstep, voffB); PG8_STAGE(PG8_SA(0, 0), cA, voffA); PG8_STAGE(PG8_SA(0, 1), cA + hstep, voffA);
        if (wr == 1) PG8_BAR;
        PG8_WAIT_V(2); PG8_BAR;
        PG8_STAGE(PG8_SB(1, 0), cB + kstep, voffB); PG8_STAGE(PG8_SA(1, 0), cA + kstep, voffA); PG8_STAGE(PG8_SB(1, 1), cB + hstep + kstep, voffB);
        PG8_WAIT_V(6); PG8_BAR;
    } else {
        PG8_STAGE(PG8_SB(0, 0), cB, voffB); PG8_STAGE(PG8_SA(0, 0), cA, voffA); PG8_STAGE(PG8_SB(0, 1), cB + hstep, voffB); PG8_STAGE(PG8_SA(0, 1), cA + hstep, voffA);
        if (wr == 1) PG8_BAR;
        PG8_WAIT_V(4); PG8_BAR;
        PG8_STAGE(PG8_SB(1, 0), cB + kstep, voffB); PG8_STAGE(PG8_SA(1, 0), cA + kstep, voffA); PG8_STAGE(PG8_SB(1, 1), cB + hstep + kstep, voffB);
        PG8_WAIT_V(6); PG8_BAR;
    }
    for (;;) {
        const bool has_next = S.next(ui + 1, nxt);
        const char* nA = has_next ? (const char*)g.A + (size_t)nxt.pm * tstep + (size_t)nxt.kt0 * (BK * 2) : cA; const char* nB = has_next ? (const char*)g.Bt + (size_t)nxt.pn * tstep + (size_t)nxt.kt0 * (BK * 2) : cB;
        const int nt = cur.nt;
        asm volatile(".p2align 8" ::: "memory");
        for (int t = 0; t < nt; t += 2) {
            const bool last = (t == nt - 2);
            const char* a1 = cA + (size_t)(t + 1) * kstep;
            const char* a2 = last ? nA : cA + (size_t)(t + 2) * kstep; const char* b2 = last ? nB : cB + (size_t)(t + 2) * kstep;
            const char* a3 = a2 + kstep; const char* b3 = b2 + kstep;
            if (last && has_next) S.a_ready(nxt);
            if constexpr (SP2) {
            PG8_LDB(B0, 0, 0); PG8_LDB(B1, 0, 1); PG8_SCHED; PG8_LDA(At, 0, 0); PG8_STAGE(PG8_SA(1, 1), a1 + hstep, voffA);
            PG8_WAIT_V(8); PG8_WAIT_L(0); PG8_BAR; PG8_MMA(0, 0, At, B0); PG8_MMA(0, 1, At, B1); PG8_BAR; PG8_SCHED;
            PG8_LDA(At, 0, 1); PG8_STAGE(PG8_SB(0, 0), b2, voffB); PG8_STAGE(PG8_SB(0, 1), b2 + hstep, voffB); PG8_STAGE(PG8_SA(0, 0), a2, voffA);
            PG8_WAIT_V(8); PG8_WAIT_L(0); PG8_BAR; PG8_MMA(1, 0, At, B0); PG8_MMA(1, 1, At, B1); PG8_BAR; PG8_SCHED;
            PG8_LDB(B0, 1, 0); PG8_LDB(B1, 1, 1); PG8_SCHED; PG8_LDA(At, 1, 0); PG8_STAGE(PG8_SA(0, 1), a2 + hstep, voffA);
            PG8_WAIT_V(8); PG8_WAIT_L(0); PG8_BAR; PG8_MMA(0, 0, At, B0); PG8_MMA(0, 1, At, B1); PG8_BAR; PG8_SCHED;
            PG8_LDA(At, 1, 1); PG8_STAGE(PG8_SB(1, 0), b3, voffB); PG8_STAGE(PG8_SB(1, 1), b3 + hstep, voffB); PG8_STAGE(PG8_SA(1, 0), a3, voffA);
            PG8_WAIT_V(8); PG8_WAIT_L(0); PG8_BAR; PG8_MMA(1, 0, At, B0); PG8_MMA(1, 1, At, B1); PG8_BAR; PG8_SCHED;
            } else {
            PG8_LDB(B0, 0, 0); PG8_SCHED; PG8_LDA(At, 0, 0); PG8_STAGE(PG8_SA(1, 1), a1 + hstep, voffA);
            PG8_WAIT_L(8); PG8_BAR; PG8_WAIT_L(0); PG8_MMA(0, 0, At, B0); PG8_BAR; PG8_SCHED;
            PG8_LDB(B1, 0, 1); PG8_STAGE(PG8_SB(0, 0), b2, voffB);
            PG8_BAR; PG8_WAIT_L(0); PG8_MMA(0, 1, At, B1); PG8_BAR;
            PG8_LDA(At, 0, 1); PG8_STAGE(PG8_SA(0, 0), a2, voffA);
            PG8_BAR; PG8_WAIT_L(0); PG8_MMA(1, 0, At, B0); PG8_BAR; PG8_SCHED;
            PG8_STAGE(PG8_SB(0, 1), b2 + hstep, voffB);
            PG8_WAIT_V(6); PG8_BAR; PG8_MMA(1, 1, At, B1); PG8_BAR;
            PG8_LDB(B0, 1, 0); PG8_SCHED; PG8_LDA(At, 1, 0); PG8_STAGE(PG8_SA(0, 1), a2 + hstep, voffA);
            PG8_WAIT_L(8); PG8_BAR; PG8_WAIT_L(0); PG8_MMA(0, 0, At, B0); PG8_BAR; PG8_SCHED;
            PG8_LDB(B1, 1, 1); PG8_STAGE(PG8_SB(1, 0), b3, voffB);
            PG8_BAR; PG8_WAIT_L(0); PG8_MMA(0, 1, At, B1); PG8_BAR;
            PG8_LDA(At, 1, 1); PG8_STAGE(PG8_SA(1, 0), a3, voffA);
            PG8_BAR; PG8_WAIT_L(0); PG8_MMA(1, 0, At, B0); PG8_BAR; PG8_SCHED;
            PG8_STAGE(PG8_SB(1, 1), b3 + hstep, voffB);
            PG8_WAIT_V(6); PG8_BAR; PG8_MMA(1, 1, At, B1); PG8_BAR;
            }
        }
        if constexpr (ALIGN_EPI) { if (wr == 0) PG8_BAR; }
        if constexpr (!Epi::AFTER_DRAIN) { E(acc, cur, wr, wc, fr, fq); S.done(cur); }
        if (!has_next) break;
#pragma unroll
        for (int a = 0; a < 2; ++a)
#pragma unroll
            for (int b = 0; b < 2; ++b)
#pragma unroll
                for (int m = 0; m < 4; ++m)
#pragma unroll
                    for (int n = 0; n < 2; ++n) acc[a][b][m][n] = (f32x4){0.f, 0.f, 0.f, 0.f};
        cur = nxt; cA = nA; cB = nB; ++ui;
        if constexpr (ALIGN_EPI) { if (wr == 1) PG8_BAR; }
    }
    PG8_WAIT_V(0);
    if constexpr (!ALIGN_EPI) { if (wr == 0) PG8_BAR; }
    PG8_BAR;
    if constexpr (Epi::AFTER_DRAIN) { E.fused(acc, cur, wr, wc, fr, fq, lds, wid, lane); S.done(cur); }
#undef PG8_SA
#undef PG8_SB
#undef PG8_STAGE
#undef PG8_LDA
#undef PG8_LDB
#undef PG8_MMA
#undef PG8_WAIT_V
#undef PG8_WAIT_L
#undef PG8_BAR
#undef PG8_SCHED
}
}
#ifndef EN_WCVT
#define EN_WCVT 1
#endif
#ifndef EN_GEMM
#define EN_GEMM 1
#endif
#ifndef EN_SCAL
#define EN_SCAL 1
#endif
#ifndef EN_PREP
#define EN_PREP 1
#endif
#ifndef EN_SCANFIN
#define EN_SCANFIN 1
#endif
#ifndef EN_SFA
#define EN_SFA 1
#endif
#ifndef EN_SFB
#define EN_SFB 1
#endif
#ifndef EN_SFC
#define EN_SFC 1
#endif
#ifndef PROBE_Q
#define PROBE_Q -1
#endif
#ifndef PROBE_REPS
#define PROBE_REPS 2
#endif
#ifndef PROBE_SCAL
#define PROBE_SCAL 1
#endif
#ifndef PROBE_SFA
#define PROBE_SFA 1
#endif
#ifndef PROBE_SFB
#define PROBE_SFB 1
#endif
#ifndef PROBE_SFC
#define PROBE_SFC 1
#endif
#ifndef PROBE_DN_W
#define PROBE_DN_W 1
#endif
#ifndef PROBE_DN_Q
#define PROBE_DN_Q 1
#endif
#ifndef PROBE_DN_BAR
#define PROBE_DN_BAR 1
#endif
#ifndef PROBE_DN_LOAD
#define PROBE_DN_LOAD 1
#endif
#ifndef PROBE_DNT
#define PROBE_DNT 0
#endif
#define DNT_K 4ull
#ifndef PROBE_DP1
#define PROBE_DP1 1
#endif
#ifndef PROBE_DP3
#define PROBE_DP3 1
#endif
#ifndef PROBE_DP4
#define PROBE_DP4 1
#endif
#ifndef PROBE_PDN
#define PROBE_PDN 1
#endif
#ifndef PROBE_PRG
#define PROBE_PRG 1
#endif
#ifndef NORM_V2
#define NORM_V2 1
#endif
#ifndef NORM_XBF
#define NORM_XBF 0
#endif
#ifndef PROBE_BAR
#define PROBE_BAR 1
#endif
#ifndef PROBE_DP0
#define PROBE_DP0 1
#endif
#ifndef PROBE_DP5
#define PROBE_DP5 1
#endif
#ifndef EN_NORM
#define EN_NORM 1
#endif
#ifndef MK_SINGLE
#define MK_SINGLE 1
#endif
constexpr int NWAVES = 8;

constexpr int DM = 1024, NB = 8, SEQ = 2048, NDB = 128, DSEQ = 8, DEPTH = 2;
constexpr int MP = NB * SEQ, MS = NDB * DSEQ, M = MP + MS;
constexpr int DFF = 2816, RGW = 512, DNH = 4, DHD = 128, CONVCH = 2048, NPROJ = 3072, INCOLS = 3080;
constexpr float EPS = 1e-6f;
constexpr size_t OFF_Y = 0, OFF_CP = 17825792, OFF_RP = 17924096, OFF_DP = 17932288, OFF_CS = 18980864, OFF_RS = 20553728, OFF_DS = 20684800, OUT_TOTAL = 37462016;
enum { I_XP = 0, I_XS, I_SCONV, I_SRG, I_SDN, I_F1PRE, I_F1UP, I_F1DN, I_F1POST, I_MPRE, I_WIN, I_CONVW, I_CONVB, I_RGWA, I_RGBA, I_RGWX, I_RGBX, I_LAM, I_ALOG, I_DTB, I_DNNW, I_WOUT, I_MPOST,
       I_F2PRE, I_F2UP, I_F2DN, I_F2POST, I_FINAL, N_IN };

constexpr size_t MiB = 1u << 20;
constexpr size_t WS_CTL = 0, CTL_ZERO_BYTES = 1 * MiB;
constexpr size_t WS_W = 2 * MiB;
constexpr size_t WO_UP1 = 0, WO_DN1 = 11534336, WO_WIN = 17301504, WO_WOUT = 23592960, WO_UP2 = 25690112, WO_DN2 = 37224448, WO_END = 42991616;
constexpr size_t WS_XN = 44 * MiB;
constexpr size_t WS_H = 78 * MiB;
constexpr size_t WS_D = 180 * MiB;
constexpr size_t WS_MIX = 248 * MiB;
constexpr size_t WS_SCAL = 282 * MiB;
constexpr size_t WS_XR = 283 * MiB;
constexpr size_t WS_END = 417 * MiB;
static_assert(WS_W + WO_END <= WS_XN && WS_XN + (size_t)M * DM * 2 <= WS_H && WS_H + (size_t)M * NPROJ * 2 <= WS_D && WS_D + (size_t)M * DM * 4 <= WS_MIX && WS_MIX + (size_t)M * DM * 2 <= WS_SCAL && WS_SCAL + (size_t)M * 32 <= WS_XR && WS_XR + (size_t)M * DM * 4 <= WS_END, "d_ws map");
constexpr size_t WS_DSLAB = WS_D + 34 * MiB;
constexpr int NSPLIT_DN = 11, NSPLIT_OUT = 4;
constexpr size_t WS_SST = 351 * MiB;
constexpr int CW_BAR = 4096;

constexpr int RING_BYTES = 131072;
constexpr int LDS_BYTES = 163840;
constexpr int LDSCTL_OFF = LDS_BYTES - 1024, MISC_OFF = LDSCTL_OFF + 320;
static_assert(MISC_OFF + 128 <= LDS_BYTES, "LDS map");

#define GAS __attribute__((address_space(1)))
#define LAS __attribute__((address_space(3)))
typedef unsigned short bf16;
typedef unsigned v4u __attribute__((ext_vector_type(4)));
typedef unsigned v2u __attribute__((ext_vector_type(2)));
typedef float f32x4 __attribute__((ext_vector_type(4)));
typedef GAS unsigned gu32;
typedef GAS unsigned long long gu64;
#define RLX_AGENT __ATOMIC_RELAXED, __HIP_MEMORY_SCOPE_AGENT
#define LDS_WAIT() asm volatile("s_waitcnt lgkmcnt(0)" ::: "memory")
#define VM_WAIT() asm volatile("s_waitcnt vmcnt(0)" ::: "memory")
#define LDS_BARRIER() do { asm volatile("s_waitcnt lgkmcnt(0)" ::: "memory"); __builtin_amdgcn_s_barrier(); asm volatile("" ::: "memory"); } while (0)
__device__ __forceinline__ unsigned f2bf(float f) { unsigned u = __builtin_bit_cast(unsigned, f); return (u + 0x7fffu + ((u >> 16) & 1u)) >> 16; }
__device__ __forceinline__ unsigned pk2(float lo, float hi) { return f2bf(lo) | (f2bf(hi) << 16); }
__device__ __forceinline__ float bf2f(bf16 v) { return __builtin_bit_cast(float, (unsigned)v << 16); }
__device__ __forceinline__ float sigmoid_f(float x) { return __builtin_amdgcn_rcpf(1.0f + __builtin_amdgcn_exp2f(-1.44269504089f * x)); }
__device__ __forceinline__ float silu_ff(float x) { return x * __builtin_amdgcn_rcpf(1.0f + __builtin_amdgcn_exp2f(-1.44269504089f * x)); }
__device__ __forceinline__ float silu_fast(float x) { return x * __builtin_amdgcn_rcpf(1.0f + __builtin_amdgcn_exp2f(-1.44269504089f * x)); }
__device__ __forceinline__ float softplus_f(float x) { return fmaxf(x, 0.0f) + log1pf(__expf(-fabsf(x))); }
__device__ __forceinline__ float gelu_tanh_f(float x) { const float u = 0.7978845608028654f * (x + 0.044715f * x * x * x); return x * sigmoid_f(2.0f * u); }
__device__ __forceinline__ float neg_expm1_f(float e) {
    const float p = -e * (1.0f + e * 0.5f * (1.0f + e * (1.0f / 3.0f) * (1.0f + e * 0.25f * (1.0f + e * 0.2f * (1.0f + e * (1.0f / 6.0f) * (1.0f + e * (1.0f / 7.0f)))))));
    return e > -0.25f ? p : 1.0f - __builtin_amdgcn_exp2f(1.44269504089f * e);
}
#define DPP_ADD(v, ctrl) ((v) + __builtin_bit_cast(float, __builtin_amdgcn_update_dpp(0, __builtin_bit_cast(int, (v)), (ctrl), 0xF, 0xF, true)))
__device__ __forceinline__ float row_sum8(float v) { v = DPP_ADD(v, 0xB1); v = DPP_ADD(v, 0x4E); v = DPP_ADD(v, 0x141); return v; }
__device__ __forceinline__ float row_sum16(float v) { v = row_sum8(v); v = DPP_ADD(v, 0x140); return v; }
__device__ __forceinline__ float wave_sum(float v) {
    v = row_sum16(v);
    const int iv = __builtin_bit_cast(int, v);
    return (__builtin_bit_cast(float, __builtin_amdgcn_readlane(iv, 0)) + __builtin_bit_cast(float, __builtin_amdgcn_readlane(iv, 16))) +
           (__builtin_bit_cast(float, __builtin_amdgcn_readlane(iv, 32)) + __builtin_bit_cast(float, __builtin_amdgcn_readlane(iv, 48)));
}

#define XB_TMO      128
#define XB_XCNT(j)  (256  + 64 * (j))
#define XB_XSUB(j)  (1280 + 64 * (j))
#define XB_XGEN(j)  (2304 + 64 * (j))
#define XB_TOP      3328
#define XB_TOPGEN   3392
#define XCD_BAR_WORDS 3456
#define XB_SPIN_CAP (1u << 18)

__device__ __forceinline__ unsigned xb_ld(unsigned* p)              { return __hip_atomic_load(p, __ATOMIC_RELAXED, __HIP_MEMORY_SCOPE_AGENT); }
__device__ __forceinline__ unsigned xb_add(unsigned* p, unsigned v) { return __hip_atomic_fetch_add(p, v, __ATOMIC_RELAXED, __HIP_MEMORY_SCOPE_AGENT); }
__device__ __forceinline__ unsigned xb_xcc_id() { return (unsigned)__builtin_amdgcn_s_getreg((3 << 11) | 20) & 0xFu; }
#define XB_SPIN(cond, bar) do { unsigned _sp = 0; while (cond) { __builtin_amdgcn_s_sleep(1); \
    if ((++_sp & 255u) == 0u) { if (xb_ld(&(bar)[XB_TMO])) break; if (_sp > XB_SPIN_CAP) { atomicAdd(&(bar)[XB_TMO], 1u); break; } } } } while (0)

struct XcdBarrier {
    unsigned* bar; unsigned x;
    volatile LAS unsigned* st;
};

__device__ __forceinline__ XcdBarrier xcd_barrier_post(unsigned* bar, volatile LAS unsigned* st) {
    XcdBarrier b; b.bar = bar; b.x = xb_xcc_id(); b.st = st;
    if (threadIdx.x == 0) (void)xb_add(&bar[XB_XCNT(b.x)], 1u);
    return b;
}
__device__ __forceinline__ void xcd_barrier_complete(unsigned* bar, unsigned x, unsigned& nloc, unsigned& nx) {
    const unsigned G = gridDim.x * gridDim.y * gridDim.z;
    unsigned sum, cnt, mine, sp = 0u;
    for (;;) {
        sum = 0u; cnt = 0u; mine = 0u;
#pragma unroll
        for (unsigned j = 0; j < 16; ++j) { const unsigned c = xb_ld(&bar[XB_XCNT(j)]); sum += c; cnt += (c > 0u) ? 1u : 0u; mine = (j == x) ? c : mine; }
        if (sum == G) break;
        __builtin_amdgcn_s_sleep(1);
        if ((++sp & 255u) == 0u) { if (xb_ld(&bar[XB_TMO])) break; if (sp > XB_SPIN_CAP) { atomicAdd(&bar[XB_TMO], 1u); break; } }
    }
    nloc = mine > 0u ? mine : 1u; nx = cnt > 0u ? cnt : 1u;
}

__device__ __forceinline__ void xcd_barrier(const XcdBarrier& b) {
    asm volatile("s_waitcnt vmcnt(0)" ::: "memory");
    __syncthreads();
    if (threadIdx.x == 0) {
        unsigned* bar = b.bar;
        __builtin_amdgcn_s_waitcnt(0);
        unsigned nloc = b.st[0], nx = b.st[1];
        if (nloc == 0u) { xcd_barrier_complete(bar, b.x, nloc, nx); b.st[0] = nloc; b.st[1] = nx; }
        const unsigned old = xb_add(&bar[XB_XSUB(b.x)], 1u);
        const unsigned gen = old / nloc;
        if (old + 1u == (gen + 1u) * nloc) {
            __builtin_amdgcn_fence(__ATOMIC_RELEASE, "agent");
            asm volatile("s_waitcnt vmcnt(0)" ::: "memory");
            const unsigned og = xb_add(&bar[XB_TOP], 1u);
            const unsigned tg = og / nx;
            if (og + 1u == (tg + 1u) * nx) xb_add(&bar[XB_TOPGEN], 1u);
            else XB_SPIN(xb_ld(&bar[XB_TOPGEN]) == tg, bar);
            __builtin_amdgcn_fence(__ATOMIC_ACQUIRE, "agent");
            xb_add(&bar[XB_XGEN(b.x)], 1u);
            asm volatile("s_waitcnt vmcnt(0)" ::: "memory");
        } else {
            XB_SPIN(xb_ld(&bar[XB_XGEN(b.x)]) == gen, bar);
            __builtin_amdgcn_fence(__ATOMIC_ACQUIRE, "agent");
            asm volatile("s_waitcnt vmcnt(0)" ::: "memory");
        }
    }
    __syncthreads();
}


constexpr int CW_QUEUE = 2048;
__device__ __forceinline__ int queue_next(gu32* ctr, volatile LAS unsigned* slot, int tid) {
    if (tid == 0) *slot = __hip_atomic_fetch_add(ctr, 1u, RLX_AGENT);
    LDS_BARRIER();
    const int it = (int)*slot;
    LDS_BARRIER();
    return it;
}


struct Args { const float* in[N_IN]; float* out; unsigned char* ws; int ph_lo, ph_hi; };

__device__ __forceinline__ void transpose_item(const float* W, int ldn, int K, bf16* WT, int k0, int n0, int drow0, LAS float* scr, int lane) {
#pragma unroll 8
    for (int i = 0; i < 32; ++i) { const int kk = 2 * i + (lane >> 5); scr[kk * 33 + (lane & 31)] = W[(size_t)(k0 + kk) * ldn + n0 + (lane & 31)]; }
    LDS_WAIT(); asm volatile("" ::: "memory");
    const int c = lane & 7;
#pragma unroll
    for (int j = 0; j < 4; ++j) { const int n = (lane >> 3) + 8 * j; const LAS float* s = scr + (8 * c) * 33 + n;
        v4u o; o.x = pk2(s[0 * 33], s[1 * 33]); o.y = pk2(s[2 * 33], s[3 * 33]); o.z = pk2(s[4 * 33], s[5 * 33]); o.w = pk2(s[6 * 33], s[7 * 33]);
        *(GAS v4u*)(WT + (size_t)(drow0 + n) * K + k0 + 8 * c) = o; }
    LDS_WAIT(); asm volatile("" ::: "memory");
}
__device__ __forceinline__ int map_up_row(int n) { return n < DFF ? ((n >> 7) << 8) + (n & 127) : (((n - DFF) >> 7) << 8) + 128 + ((n - DFF) & 127); }

constexpr int WI_UP = 16 * 176, WI_DN = 44 * 32, WI_IN = 16 * 96, WI_OUT = 16 * 32;
constexpr int WI_0 = 0, WI_1 = WI_UP + WI_DN  , WI_2 = WI_1 + WI_IN  , WI_3 = WI_2 + WI_OUT + WI_UP + WI_DN  ;
__device__ __forceinline__ void wcvt_range(const Args& a, int l, int it_lo, int it_hi, int worker, int nworkers, LAS unsigned char* lds, int wave, int lane) {
    LAS float* scr = (LAS float*)(lds + wave * 16384);
    bf16* wbase = (bf16*)(a.ws + WS_W);
    constexpr int I_UP = WI_UP, I_DN = WI_DN, I_IN = WI_IN, I_OUT = WI_OUT;
    for (int it = it_lo + worker; it < it_hi; it += nworkers) {
        int r = it; const float* W; int ldn, K, nblk; size_t wo; bool up = false;
        if (r < I_UP) { W = a.in[I_F1UP] + (size_t)l * DM * 2 * DFF; ldn = 2 * DFF; K = DM; nblk = 176; wo = WO_UP1; up = true; }
        else if ((r -= I_UP) < I_DN) { W = a.in[I_F1DN] + (size_t)l * DFF * DM; ldn = DM; K = DFF; nblk = 32; wo = WO_DN1; }
        else if ((r -= I_DN) < I_IN) { W = a.in[I_WIN] + (size_t)l * DM * INCOLS; ldn = INCOLS; K = DM; nblk = 96; wo = WO_WIN; }
        else if ((r -= I_IN) < I_OUT) { W = a.in[I_WOUT] + (size_t)l * DM * DM; ldn = DM; K = DM; nblk = 32; wo = WO_WOUT; }
        else if ((r -= I_OUT) < I_UP) { W = a.in[I_F2UP] + (size_t)l * DM * 2 * DFF; ldn = 2 * DFF; K = DM; nblk = 176; wo = WO_UP2; up = true; }
        else { r -= I_UP; W = a.in[I_F2DN] + (size_t)l * DFF * DM; ldn = DM; K = DFF; nblk = 32; wo = WO_DN2; }
        const int kb = r / nblk, nb = r % nblk, n0 = 32 * nb;
        transpose_item(W, ldn, K, (bf16*)((unsigned char*)wbase + wo), 64 * kb, n0, up ? map_up_row(n0) : n0, scr, lane);
    }
}

__device__ __forceinline__ const float* x_in_row(const Args& a, int m) { return m < MP ? a.in[I_XP] + (size_t)m * DM : a.in[I_XS] + (size_t)(m - MP) * DM; }

__device__ __forceinline__ void xn0_phase(const Args& a, int wave, int lane) {
    const int gw = blockIdx.x * NWAVES + wave, NGW = gridDim.x * NWAVES;
    const float* g = a.in[I_F1PRE];
    f32x4 gv[4];
#pragma unroll
    for (int j = 0; j < 4; ++j) gv[j] = ((const f32x4*)g)[lane + 64 * j];
    for (int m = gw; m < M; m += NGW) {
        const f32x4* xr = (const f32x4*)x_in_row(a, m) + lane;
        f32x4 v[4]; float s = 0.f;
#pragma unroll
        for (int j = 0; j < 4; ++j) { v[j] = xr[64 * j]; s += (v[j].x * v[j].x + v[j].y * v[j].y) + (v[j].z * v[j].z + v[j].w * v[j].w); }
        const float rstd = rsqrtf(wave_sum(s) * (1.0f / DM) + EPS);
        unsigned long long* o8 = (unsigned long long*)((bf16*)(a.ws + WS_XN) + (size_t)m * DM) + lane;
#pragma unroll
        for (int j = 0; j < 4; ++j) { const f32x4 y = v[j] * rstd * gv[j]; o8[64 * j] = (unsigned long long)pk2(y.x, y.y) | ((unsigned long long)pk2(y.z, y.w) << 32); }
    }
}

__device__ __forceinline__ f32x4 bf4_to_f32(v2u w) { return (f32x4){__builtin_bit_cast(float, w.x << 16), __builtin_bit_cast(float, w.x & 0xffff0000u), __builtin_bit_cast(float, w.y << 16), __builtin_bit_cast(float, w.y & 0xffff0000u)}; }
__device__ __forceinline__ void norm_phase(const Args& a, const float* gpost, const float* gnext, float alpha, int kn, bool last, int nsplit, int wave, int lane) {
    const int gw = blockIdx.x * NWAVES + wave, NGW = gridDim.x * NWAVES;
    f32x4 gp[4], gn[4];
#pragma unroll
    for (int j = 0; j < 4; ++j) { gp[j] = ((const f32x4*)gpost)[lane + 64 * j]; gn[j] = ((const f32x4*)gnext)[lane + 64 * j]; }
    const bf16* D = (const bf16*)(a.ws + WS_D);
    const float* xsrc = (kn & 1) ? (const float*)(a.ws + WS_XR) : a.out + OFF_Y;
    float* xdst = (kn & 1) ? a.out + OFF_Y : (float*)(a.ws + WS_XR);
#if NORM_XBF
    const bf16* xsb = (const bf16*)(a.ws + WS_XR) + (size_t)(kn & 1) * M * DM;
    bf16* xdb = (bf16*)(a.ws + WS_XR) + (size_t)((kn + 1) & 1) * M * DM;
#endif
    constexpr int NR = 4;
    for (int m0 = gw; m0 < M; m0 += NR * NGW) {
        f32x4 d[NR][4], x[NR][4]; float s[NR];
#pragma unroll
        for (int rr = 0; rr < NR; ++rr) { const int m = m0 + rr * NGW; s[rr] = 0.f;
            if (m < M) {
                const v2u* dr = (const v2u*)(D + (size_t)m * DM) + lane;
                const f32x4* xr = (kn == 0 ? (const f32x4*)x_in_row(a, m) : (const f32x4*)(xsrc + (size_t)m * DM)) + lane;
#pragma unroll
                for (int j = 0; j < 4; ++j) {
#if NORM_XBF
                    x[rr][j] = kn == 0 ? xr[64 * j] : bf4_to_f32(((const v2u*)(xsb + (size_t)m * DM) + lane)[64 * j]);
#else
                    x[rr][j] = xr[64 * j];
#endif
                    if (m < MP) d[rr][j] = bf4_to_f32(dr[64 * j]);
                    else { d[rr][j] = (f32x4){0.f, 0.f, 0.f, 0.f};
                        for (int sp = 0; sp < nsplit; ++sp) d[rr][j] += bf4_to_f32(((const v2u*)((const bf16*)(a.ws + WS_DSLAB) + ((size_t)sp * MS + (m - MP)) * DM) + lane)[64 * j]); }
                    s[rr] += (d[rr][j].x * d[rr][j].x + d[rr][j].y * d[rr][j].y) + (d[rr][j].z * d[rr][j].z + d[rr][j].w * d[rr][j].w); } } }
#pragma unroll
        for (int rr = 0; rr < NR; ++rr) { const int m = m0 + rr * NGW;
            if (m < M) {
                const float rs = alpha * rsqrtf(wave_sum(s[rr]) * (1.0f / DM) + EPS);
                float s2 = 0.f;
#pragma unroll
                for (int j = 0; j < 4; ++j) { x[rr][j] = x[rr][j] + d[rr][j] * rs * gp[j]; s2 += (x[rr][j].x * x[rr][j].x + x[rr][j].y * x[rr][j].y) + (x[rr][j].z * x[rr][j].z + x[rr][j].w * x[rr][j].w); }
                const float rs2 = rsqrtf(wave_sum(s2) * (1.0f / DM) + EPS);
                f32x4* xo = (f32x4*)((NORM_XBF && last ? a.out + OFF_Y : xdst) + (size_t)m * DM) + lane;
                if (last) {
#pragma unroll
                    for (int j = 0; j < 4; ++j) xo[64 * j] = x[rr][j] * rs2 * gn[j];
                } else {
                    v2u* o8 = (v2u*)((bf16*)(a.ws + WS_XN) + (size_t)m * DM) + lane;
#pragma unroll
                    for (int j = 0; j < 4; ++j) {
#if NORM_XBF
                        { v2u xw; xw.x = pk2(x[rr][j].x, x[rr][j].y); xw.y = pk2(x[rr][j].z, x[rr][j].w); ((v2u*)(xdb + (size_t)m * DM) + lane)[64 * j] = xw; }
#else
                        xo[64 * j] = x[rr][j];
#endif
                        const f32x4 y = x[rr][j] * rs2 * gn[j]; v2u yw; yw.x = pk2(y.x, y.y); yw.y = pk2(y.z, y.w); o8[64 * j] = yw; }
                }
            } }
    }
}

#define NV2_DOT(v) (((v).x * (v).x + (v).y * (v).y) + ((v).z * (v).z + (v).w * (v).w))
#define NV2_FINISH(xr_, dr_, m_) do { \
        float s_ = 0.f; \
        _Pragma("unroll") for (int j = 0; j < 4; ++j) s_ += NV2_DOT(dr_[j]); \
        const float rs_ = alpha * rsqrtf(wave_sum(s_) * (1.0f / DM) + EPS); float s2_ = 0.f; \
        _Pragma("unroll") for (int j = 0; j < 4; ++j) { xr_[j] = xr_[j] + dr_[j] * rs_ * gp[j]; s2_ += NV2_DOT(xr_[j]); } \
        const float rs2_ = rsqrtf(wave_sum(s2_) * (1.0f / DM) + EPS); \
        f32x4* xo_ = (f32x4*)(xdst + (size_t)(m_) * DM) + lane; \
        if (last) { _Pragma("unroll") for (int j = 0; j < 4; ++j) xo_[64 * j] = xr_[j] * rs2_ * gn[j]; } \
        else { v2u* o8_ = (v2u*)((bf16*)(a.ws + WS_XN) + (size_t)(m_) * DM) + lane; \
            _Pragma("unroll") for (int j = 0; j < 4; ++j) { xo_[64 * j] = xr_[j]; const f32x4 y_ = xr_[j] * rs2_ * gn[j]; v2u yw_; yw_.x = pk2(y_.x, y_.y); yw_.y = pk2(y_.z, y_.w); o8_[64 * j] = yw_; } } } while (0)
#define NV2_LOAD(dS, xS, m0_) do { _Pragma("unroll") for (int rr = 0; rr < 2; ++rr) { const int m_ = (m0_) + rr * NGW; \
        if (m_ < MP) { const v2u* dr_ = (const v2u*)(D + (size_t)m_ * DM) + lane; const f32x4* xr_ = (kn == 0 ? (const f32x4*)x_in_row(a, m_) : (const f32x4*)(xsrc + (size_t)m_ * DM)) + lane; \
            _Pragma("unroll") for (int j = 0; j < 4; ++j) { dS[rr][j] = dr_[64 * j]; xS[rr][j] = xr_[64 * j]; } } } } while (0)
#define NV2_PROC(dS, xS, m0_) do { _Pragma("unroll") for (int rr = 0; rr < 2; ++rr) { const int m_ = (m0_) + rr * NGW; \
        if (m_ < MP) { f32x4 df_[4]; _Pragma("unroll") for (int j = 0; j < 4; ++j) df_[j] = bf4_to_f32(dS[rr][j]); NV2_FINISH(xS[rr], df_, m_); } } } while (0)
#define NV2_SAMPLE(NS) do { v2u sl_[NS][4]; \
        _Pragma("unroll") for (int sp = 0; sp < NS; ++sp) _Pragma("unroll") for (int j = 0; j < 4; ++j) sl_[sp][j] = ((const v2u*)((const bf16*)(a.ws + WS_DSLAB) + ((size_t)sp * MS + r) * DM) + lane)[64 * j]; \
        _Pragma("unroll") for (int j = 0; j < 4; ++j) { df[j] = bf4_to_f32(sl_[0][j]); _Pragma("unroll") for (int sp = 1; sp < NS; ++sp) df[j] += bf4_to_f32(sl_[sp][j]); } } while (0)
__device__ __forceinline__ void norm_phase2(const Args& a, const float* gpost, const float* gnext, float alpha, int kn, bool last, int nsplit, int wave, int lane) {
    const int gw = blockIdx.x * NWAVES + wave, NGW = gridDim.x * NWAVES;
    f32x4 gp[4], gn[4];
#pragma unroll
    for (int j = 0; j < 4; ++j) { gp[j] = ((const f32x4*)gpost)[lane + 64 * j]; gn[j] = ((const f32x4*)gnext)[lane + 64 * j]; }
    const bf16* D = (const bf16*)(a.ws + WS_D);
    const float* xsrc = (kn & 1) ? (const float*)(a.ws + WS_XR) : a.out + OFF_Y;
    float* xdst = (kn & 1) ? a.out + OFF_Y : (float*)(a.ws + WS_XR);
    v2u dA[2][4], dB[2][4]; f32x4 xA[2][4], xB[2][4];
    int m0 = gw;
    if (m0 < MP) NV2_LOAD(dA, xA, m0);
    if (!(gw & 1)) for (int r = gw >> 1; r < MS; r += NGW >> 1) {
        const int m = MP + r;
        f32x4 xs[4], df[4];
        const f32x4* xr = (kn == 0 ? (const f32x4*)x_in_row(a, m) : (const f32x4*)(xsrc + (size_t)m * DM)) + lane;
#pragma unroll
        for (int j = 0; j < 4; ++j) xs[j] = xr[64 * j];
        if (nsplit == NSPLIT_DN) NV2_SAMPLE(NSPLIT_DN); else NV2_SAMPLE(NSPLIT_OUT);
        NV2_FINISH(xs, df, m);
    }
    while (m0 < MP) {
        const int m1 = m0 + 2 * NGW;
        if (m1 < MP) NV2_LOAD(dB, xB, m1);
        NV2_PROC(dA, xA, m0);
        if (m1 >= MP) break;
        const int m2 = m1 + 2 * NGW;
        if (m2 < MP) NV2_LOAD(dA, xA, m2);
        NV2_PROC(dB, xB, m1);
        m0 = m2;
    }
}

__device__ __forceinline__ void scal_phase(const Args& a, int l, LAS unsigned char* lds, int tid, int wave, int lane) {
    const int gw = blockIdx.x * NWAVES + wave, NGW = gridDim.x * NWAVES;
    const float* wl = a.in[I_WIN] + (size_t)l * DM * INCOLS + NPROJ;
    LAS float* wsm = (LAS float*)lds;
#pragma unroll
    for (int n = 0; n < 4; ++n) { const int p = tid + 512 * n; *(LAS f32x4*)(wsm + 4 * p + 4 * (p >> 4)) = *(const f32x4*)(wl + (size_t)(p >> 1) * INCOLS + 4 * (p & 1)); }
    __syncthreads();
    const bf16* XN = (const bf16*)(a.ws + WS_XN);
    float* SC = (float*)(a.ws + WS_SCAL);
    for (int m = gw; m < M; m += NGW) {
        float acc[8];
#pragma unroll
        for (int j = 0; j < 8; ++j) acc[j] = 0.f;
#pragma unroll
        for (int jj = 0; jj < 2; ++jj) {
            const int k0 = 8 * lane + 512 * jj;
            const v4u x0 = *(const v4u*)(XN + (size_t)m * DM + k0);
            const unsigned xw[4] = {x0.x, x0.y, x0.z, x0.w};
#pragma unroll
            for (int i = 0; i < 8; ++i) {
                const float xv = (i & 1) ? __builtin_bit_cast(float, xw[i >> 1] & 0xffff0000u) : __builtin_bit_cast(float, xw[i >> 1] << 16);
                const f32x4 w0 = *(const LAS f32x4*)(wsm + (k0 + i) * 8 + (k0 >> 1)), w1 = *(const LAS f32x4*)(wsm + (k0 + i) * 8 + (k0 >> 1) + 4);
                acc[0] += xv * w0.x; acc[1] += xv * w0.y; acc[2] += xv * w0.z; acc[3] += xv * w0.w;
                acc[4] += xv * w1.x; acc[5] += xv * w1.y; acc[6] += xv * w1.z; acc[7] += xv * w1.w;
            }
        }
#pragma unroll
        for (int j = 0; j < 8; ++j) acc[j] = wave_sum(acc[j]);
        if (lane == 0) { f32x4* o = (f32x4*)(SC + (size_t)m * 8); o[0] = (f32x4){acc[0], acc[1], acc[2], acc[3]}; o[1] = (f32x4){acc[4], acc[5], acc[6], acc[7]}; }
    }
    __syncthreads();
}

__device__ __forceinline__ float conv_src(const Args& a, int l, int m, int ch, int back) {
    const bf16* PROJ = (const bf16*)(a.ws + WS_H);
    const int t = m < MP ? (m & (SEQ - 1)) : ((m - MP) & (DSEQ - 1));
    const int ts = t - back;
    if (ts >= 0) return bf2f(PROJ[(size_t)(m - back) * NPROJ + ch]);
    if (m < MP) return 0.f;
    const int bs = (m - MP) >> 3;
    return a.in[I_SCONV][((size_t)(l * NDB + bs) * 3 + (3 + ts)) * CONVCH + ch];
}

__device__ __forceinline__ void delta_seq(const Args& a, int l, int item, LAS unsigned char* lds, int tid) {
    asm volatile("" : "+v"(tid));
    LAS float* qs = (LAS float*)lds;
    LAS float* ks = qs + 256;
    LAS float* red = ks + 256;
    LAS float* red2 = red + 16;
    const int bs = item >> 1, hl = __builtin_amdgcn_readfirstlane(tid >> 8), h = 2 * (item & 1) + hl, e = (tid & 255) >> 1, half = tid & 1, lane = tid & 63, wave = __builtin_amdgcn_readfirstlane(tid >> 6);
    const int m0 = MP + bs * DSEQ, chq = 512 + h * 128 + e;
    float s[64];
    { const float* S0 = a.in[I_SDN] + (((size_t)(l * NDB + bs) * DNH + h) << 14) + (size_t)(64 * half) * 128 + e;
#pragma unroll
      for (int d = 0; d < 64; ++d) s[d] = S0[d * 128]; }
    const float* cw = a.in[I_CONVW] + (size_t)l * 4 * CONVCH;
    float wq[4], wk[4], wv[4], hq[3], hk[3], hv[3];
#pragma unroll
    for (int t = 0; t < 4; ++t) { wq[t] = cw[t * CONVCH + chq]; wk[t] = cw[t * CONVCH + 512 + chq]; wv[t] = cw[t * CONVCH + 1024 + chq]; }
#pragma unroll
    for (int r = 0; r < 3; ++r) { const float* sc = a.in[I_SCONV] + ((size_t)(l * NDB + bs) * 3 + r) * CONVCH; hq[r] = sc[chq]; hk[r] = sc[512 + chq]; hv[r] = sc[1024 + chq]; }
    const float negA = -__expf(a.in[I_ALOG][l * DNH + h]), dtb = a.in[I_DTB][l * DNH + h], nw = a.in[I_DNNW][l * DHD + e];
    const bf16* PROJ = (const bf16*)(a.ws + WS_H); const float* SC = (const float*)(a.ws + WS_SCAL); bf16* MIX = (bf16*)(a.ws + WS_MIX);
    for (int t = 0; t < DSEQ; ++t) {
        const int m = m0 + t; const bf16* prow = PROJ + (size_t)m * NPROJ;
        const float xq = bf2f(prow[chq]), xk = bf2f(prow[512 + chq]), xv = bf2f(prow[1024 + chq]), z = bf2f(prow[2048 + chq]);
        const float sb = SC[(size_t)m * 8 + h], sg = SC[(size_t)m * 8 + 4 + h];
        const float cq = wq[0] * hq[0] + wq[1] * hq[1] + wq[2] * hq[2] + wq[3] * xq; hq[0] = hq[1]; hq[1] = hq[2]; hq[2] = xq;
        const float ck = wk[0] * hk[0] + wk[1] * hk[1] + wk[2] * hk[2] + wk[3] * xk; hk[0] = hk[1]; hk[1] = hk[2]; hk[2] = xk;
        const float cv = wv[0] * hv[0] + wv[1] * hv[1] + wv[2] * hv[2] + wv[3] * xv; hv[0] = hv[1]; hv[1] = hv[2]; hv[2] = xv;
        const float sq_ = silu_ff(cq), sk = silu_ff(ck), sv = silu_ff(cv);
        const float ssq = wave_sum(half ? 0.f : sq_ * sq_), ssk = wave_sum(half ? 0.f : sk * sk);
        if (lane == 0) { red[wave * 2] = ssq; red[wave * 2 + 1] = ssk; }
        LDS_BARRIER();
        const float tq = (red[8 * hl] + red[8 * hl + 2]) + (red[8 * hl + 4] + red[8 * hl + 6]), tk = (red[8 * hl + 1] + red[8 * hl + 3]) + (red[8 * hl + 5] + red[8 * hl + 7]);
        if (!half) { qs[hl * 128 + e] = sq_ * rsqrtf(tq + EPS) * 0.08838834764831845f; ks[hl * 128 + e] = sk * rsqrtf(tk + EPS); }
        LDS_BARRIER();
        const float beta = sigmoid_f(sb), eg = __expf(negA * softplus_f(sg + dtb));
        const LAS float* kh = ks + hl * 128 + 64 * half; const LAS float* qh = qs + hl * 128 + 64 * half;
        float dot = 0.f;
#pragma unroll
        for (int d = 0; d < 64; d += 4) { const f32x4 k4 = *(const LAS f32x4*)(kh + d); dot += k4.x * s[d] + k4.y * s[d + 1] + k4.z * s[d + 2] + k4.w * s[d + 3]; }
        dot += __shfl_xor(dot, 1);
        const float c = beta * (sv - eg * dot);
        float o = 0.f;
#pragma unroll
        for (int d = 0; d < 64; d += 4) { const f32x4 k4 = *(const LAS f32x4*)(kh + d); const f32x4 q4 = *(const LAS f32x4*)(qh + d);
            s[d] = eg * s[d] + k4.x * c; s[d + 1] = eg * s[d + 1] + k4.y * c; s[d + 2] = eg * s[d + 2] + k4.z * c; s[d + 3] = eg * s[d + 3] + k4.w * c;
            o += q4.x * s[d] + q4.y * s[d + 1] + q4.z * s[d + 2] + q4.w * s[d + 3]; }
        o += __shfl_xor(o, 1);
        const float sso = wave_sum(half ? 0.f : o * o);
        if (lane == 0) red2[wave] = sso;
        LDS_BARRIER();
        const float rstd = rsqrtf(((red2[4 * hl] + red2[4 * hl + 1]) + (red2[4 * hl + 2] + red2[4 * hl + 3])) * (1.0f / DHD) + EPS);
        if (!half) MIX[(size_t)m * DM + chq] = (bf16)f2bf(o * rstd * nw * silu_ff(z));
    }
    float* So = a.out + OFF_DS + (((size_t)(l * NDB + bs) * DNH + h) << 14) + (size_t)(64 * half) * 128 + e;
#pragma unroll
    for (int d = 0; d < 64; ++d) So[d * 128] = s[d];
    LDS_BARRIER();
}

constexpr size_t DI_W = WS_D, DI_QG = WS_D + 16 * MiB, DI_KGT = WS_D + 32 * MiB, DI_U = WS_D + 48 * MiB, DI_ATT = WS_XN, DI_EGL = WS_XN + 8 * MiB;
typedef short bf16x8v __attribute__((ext_vector_type(8)));
typedef float f32x2_t __attribute__((ext_vector_type(2)));
typedef __bf16 bf16x2_t __attribute__((ext_vector_type(2)));
__device__ __forceinline__ unsigned cvtpk_s(float lo, float hi) { f32x2_t v = {lo, hi}; bf16x2_t b = __builtin_convertvector(v, bf16x2_t); return __builtin_bit_cast(unsigned, b); }
__device__ __forceinline__ bf16x8v pack8(const f32x4 lo4, const f32x4 hi4) { v4u w; w.x = cvtpk_s(lo4[0], lo4[1]); w.y = cvtpk_s(lo4[2], lo4[3]); w.z = cvtpk_s(hi4[0], hi4[1]); w.w = cvtpk_s(hi4[2], hi4[3]); return __builtin_bit_cast(bf16x8v, w); }
__device__ __forceinline__ int perm32k(int x) { return 8 * ((x >> 2) & 3) + 4 * (x >> 4) + (x & 3); }

constexpr int VBSTR = 136, RAWSTR = 392, ASTR = 68, TDSTR = 20;
constexpr int DP_QB = 0, DP_KB = 17408, DP_VB = 34816, DP_AM = 52224, DP_RAW = 52224, DP_GS = DP_RAW + 67 * RAWSTR * 2, DP_BS = DP_GS + 256, DP_CW = DP_BS + 256, DP_TD = DP_CW + 6144, DP_END = DP_TD + 4 * 16 * TDSTR * 4;
static_assert(DP_VB + 64 * VBSTR * 2 <= DP_AM && DP_END <= LDSCTL_OFF && DP_GS % 16 == 0, "DNPREP LDS map");
__device__ __forceinline__ void dnprep_item(const Args& a, int l, int it, LAS unsigned char* lds, int tid) {
    asm volatile("" : "+v"(tid));
    LAS bf16* qb = (LAS bf16*)(lds + DP_QB);
    LAS bf16* kb = (LAS bf16*)(lds + DP_KB);
    LAS bf16* vb = (LAS bf16*)(lds + DP_VB);
    LAS float* Am = (LAS float*)(lds + DP_AM);
    LAS float* Td = (LAS float*)(lds + DP_TD);
    LAS bf16* raw = (LAS bf16*)(lds + DP_RAW);
    LAS float* Gs = (LAS float*)(lds + DP_GS);
    LAS float* bs = (LAS float*)(lds + DP_BS);
    LAS float* cw = (LAS float*)(lds + DP_CW);
    const int lane = tid & 63, wave = __builtin_amdgcn_readfirstlane(tid >> 6), q4 = lane >> 4, r16 = lane & 15;
    const int c = it & 31, h = (it >> 5) & 3, b = it >> 7;
    const bf16* PROJ = (const bf16*)(a.ws + WS_H);
    const int mbase = b * SEQ + 64 * c;
    _Pragma("unroll 1") for (int pr0 = 0; pr0 < PROBE_DP0; ++pr0) {
        if (pr0 > 0) LDS_BARRIER();
        v4u pv[7];
#pragma unroll
        for (int n = 0; n < 7; ++n) { const int p = tid + 512 * n; pv[n] = (v4u){0u, 0u, 0u, 0u};
            if (p < 67 * 48) { const int slot = p / 48, pc = p - slot * 48;
                if (64 * c + slot - 3 >= 0) pv[n] = *(const v4u*)(PROJ + (size_t)(mbase - 3 + slot) * NPROJ + 512 * (1 + (pc >> 4)) + 128 * h + 8 * (pc & 15)); } }
        f32x4 wv = (f32x4){0.f, 0.f, 0.f, 0.f};
        if (tid < 384) { const int which = tid >> 7, tap = (tid >> 5) & 3, f4 = tid & 31; wv = *(const f32x4*)(a.in[I_CONVW] + ((size_t)l * 4 + tap) * CONVCH + 512 * (1 + which) + 128 * h + 4 * f4); }
        if (wave == 0) {
            const float* SC = (const float*)(a.ws + WS_SCAL) + (size_t)(mbase + lane) * 8;
            const float beta = sigmoid_f(SC[h]);
            float G = -__expf(a.in[I_ALOG][l * DNH + h]) * softplus_f(SC[4 + h] + a.in[I_DTB][l * DNH + h]);
#pragma unroll
            for (int off = 1; off < 64; off <<= 1) { const float tt = __shfl_up(G, off); if (lane >= off) G += tt; }
            Gs[lane] = G; bs[lane] = beta;
            if (lane == 63) ((float*)(a.ws + DI_EGL))[it] = __expf(G);
        }
#pragma unroll
        for (int n = 0; n < 7; ++n) { const int p = tid + 512 * n; if (p < 67 * 48) { const int slot = p / 48, pc = p - slot * 48; *(LAS v4u*)(raw + slot * RAWSTR + 8 * pc) = pv[n]; } }
        if (tid < 384) *(LAS f32x4*)(cw + 4 * tid) = wv;
    }
    LDS_BARRIER();
    _Pragma("unroll 1") for (int pr1 = 0; pr1 < PROBE_DP1; ++pr1) {
        const int i = tid >> 3, sub = tid & 7;
#pragma unroll
        for (int which = 0; which < 3; ++which) {
            float o[16];
#pragma unroll
            for (int x = 0; x < 16; ++x) o[x] = 0.f;
#pragma unroll
            for (int tap = 0; tap < 4; ++tap) {
                const LAS v4u* xp = (const LAS v4u*)(raw + (i + tap) * RAWSTR + which * 128 + 16 * sub);
                const v4u x0 = xp[0], x1 = xp[1];
                const LAS f32x4* wp = (const LAS f32x4*)(cw + (which * 4 + tap) * 128 + 16 * sub);
                const f32x4 w0 = wp[0], w1 = wp[1], w2 = wp[2], w3 = wp[3];
                const unsigned xw[8] = {x0.x, x0.y, x0.z, x0.w, x1.x, x1.y, x1.z, x1.w};
                const float wv[16] = {w0.x, w0.y, w0.z, w0.w, w1.x, w1.y, w1.z, w1.w, w2.x, w2.y, w2.z, w2.w, w3.x, w3.y, w3.z, w3.w};
#pragma unroll
                for (int x = 0; x < 16; ++x) { const float xv = (x & 1) ? __builtin_bit_cast(float, xw[x >> 1] & 0xffff0000u) : __builtin_bit_cast(float, xw[x >> 1] << 16); o[x] += wv[x] * xv; }
            }
            float ss = 0.f;
#pragma unroll
            for (int x = 0; x < 16; ++x) { o[x] = silu_ff(o[x]); ss += o[x] * o[x]; }
            ss = row_sum8(ss);
            const float sc = which == 0 ? __builtin_amdgcn_rsqf(ss + EPS) * 0.08838834764831845f : (which == 1 ? __builtin_amdgcn_rsqf(ss + EPS) : 1.0f);
            v4u w0, w1; w0.x = cvtpk_s(o[0] * sc, o[1] * sc); w0.y = cvtpk_s(o[2] * sc, o[3] * sc); w0.z = cvtpk_s(o[4] * sc, o[5] * sc); w0.w = cvtpk_s(o[6] * sc, o[7] * sc);
            w1.x = cvtpk_s(o[8] * sc, o[9] * sc); w1.y = cvtpk_s(o[10] * sc, o[11] * sc); w1.z = cvtpk_s(o[12] * sc, o[13] * sc); w1.w = cvtpk_s(o[14] * sc, o[15] * sc);
            LAS v4u* dst = (LAS v4u*)((which == 0 ? qb : (which == 1 ? kb : vb)) + i * VBSTR + 16 * sub); dst[0] = w0; dst[1] = w1;
            asm volatile("" ::: "memory");
        }
    }
    LDS_BARRIER();
    bf16* ATT = (bf16*)(a.ws + DI_ATT) + (size_t)it * 4096;
    _Pragma("unroll 1") for (int pr3 = 0; pr3 < PROBE_DP3; ++pr3)
    for (int jb = wave; jb < 26; jb += 8) {
        if (jb >= 20) {
            const int z = jb - 20, ti = z < 3 ? 0 : (z < 5 ? 1 : 2), tj = z < 3 ? z + 1 : (z < 5 ? z - 1 : 3);
#pragma unroll
            for (int r = 0; r < 4; ++r) { const int i = 16 * ti + 4 * q4 + r, j = 16 * tj + r16; ATT[i * 64 + (j & 32) + perm32k(j & 31)] = (bf16)0; }
            continue;
        }
        const bool iskk = jb < 10; const int jl = iskk ? jb : jb - 10;
        const int ti = jl >= 6 ? 3 : (jl >= 3 ? 2 : (jl >= 1 ? 1 : 0)), tj = jl - (ti * (ti + 1)) / 2;
        const LAS bf16* X = (iskk ? kb : qb) + (16 * ti + r16) * VBSTR + 8 * q4;
        const LAS bf16* Kp = kb + (16 * tj + r16) * VBSTR + 8 * q4;
        bf16x8v xa[4], kf[4];
#pragma unroll
        for (int kk = 0; kk < 4; ++kk) { xa[kk] = *(const LAS bf16x8v*)(X + 32 * kk); kf[kk] = *(const LAS bf16x8v*)(Kp + 32 * kk); }
        f32x4 acc = (f32x4){0.f, 0.f, 0.f, 0.f};
#pragma unroll
        for (int kk = 0; kk < 4; ++kk) acc = __builtin_amdgcn_mfma_f32_16x16x32_bf16(xa[kk], kf[kk], acc, 0, 0, 0);
        const int j = 16 * tj + r16; const float Gj = Gs[j];
#pragma unroll
        for (int r = 0; r < 4; ++r) { const int i = 16 * ti + 4 * q4 + r;
            const float dec = __expf(i >= j ? Gs[i] - Gj : 0.f);
            if (iskk) Am[i * ASTR + j] = i > j ? bs[i] * acc[r] * dec : 0.f;
            else ATT[i * 64 + (j & 32) + perm32k(j & 31)] = (bf16)f2bf(i >= j ? acc[r] * dec : 0.f); }
    }
    LDS_BARRIER();
    _Pragma("unroll 1") for (int pr4 = 0; pr4 < PROBE_DP4; ++pr4) {
    if (wave == 0) {
        const int bb = lane >> 4, cc = lane & 15;
        const LAS float* Ab = Am + (16 * bb) * ASTR + 16 * bb;
        float x[16];
#pragma unroll
        for (int i = 0; i < 16; ++i) {
            float acc = (i == cc) ? 1.0f : 0.0f;
#pragma unroll
            for (int j4 = 0; 4 * j4 < i; ++j4) { const f32x4 a4 = *(const LAS f32x4*)(Ab + i * ASTR + 4 * j4);
                acc -= a4.x * x[4 * j4];
                if (4 * j4 + 1 < i) acc -= a4.y * x[4 * j4 + 1];
                if (4 * j4 + 2 < i) acc -= a4.z * x[4 * j4 + 2];
                if (4 * j4 + 3 < i) acc -= a4.w * x[4 * j4 + 3]; }
            x[i] = acc;
            Td[(bb * 16 + i) * TDSTR + cc] = acc;
        }
    } else {
        bf16* QG = (bf16*)(a.ws + DI_QG) + (size_t)it * 8192; bf16* KGT = (bf16*)(a.ws + DI_KGT) + (size_t)it * 8192; const float G63 = Gs[63];
        for (int p = tid - 64; p < 1024; p += 448) {
            { const int i = p >> 4, g32 = (p >> 2) & 3, q = p & 3; const float eg = __expf(Gs[i]);
              const v2u lo2 = *(const LAS v2u*)(qb + i * VBSTR + 32 * g32 + 4 * q), hi2 = *(const LAS v2u*)(qb + i * VBSTR + 32 * g32 + 16 + 4 * q);
              *(v4u*)(QG + i * 128 + 32 * g32 + 8 * q) = __builtin_bit_cast(v4u, pack8(bf4_to_f32(lo2) * eg, bf4_to_f32(hi2) * eg)); }
            { const int dd = p >> 3, g32 = (p >> 2) & 1, q = p & 3;
              f32x4 lo, hi;
#pragma unroll
              for (int x = 0; x < 4; ++x) { const int t0 = 32 * g32 + 4 * q + x, t1 = t0 + 16; lo[x] = bf2f(kb[t0 * VBSTR + dd]) * __expf(G63 - Gs[t0]); hi[x] = bf2f(kb[t1 * VBSTR + dd]) * __expf(G63 - Gs[t1]); }
              *(v4u*)(KGT + dd * 64 + 32 * g32 + 8 * q) = __builtin_bit_cast(v4u, pack8(lo, hi)); } }
    }
    LDS_BARRIER();
    {
        const bool isu = wave < 4;
        const LAS bf16* src = isu ? vb : kb;
        bf16* dbase = isu ? (bf16*)(a.ws + DI_U) + (size_t)it * 8192 : (bf16*)(a.ws + DI_W) + (size_t)it * 8192;
        int ccol[2], dcol[2];
#pragma unroll
        for (int ct = 0; ct < 2; ++ct) { ccol[ct] = (32 * wave + 16 * ct + r16) & 127; dcol[ct] = isu ? ccol[ct] : (ccol[ct] & 96) + perm32k(ccol[ct] & 31); }
        f32x4 X[2][4];
#pragma unroll
        for (int bq = 0; bq < 4; ++bq) {
            f32x4 acc[2]; acc[0] = (f32x4){0.f, 0.f, 0.f, 0.f}; acc[1] = acc[0];
#pragma unroll
            for (int j = 0; j < bq; ++j) { const f32x4 a4 = *(const LAS f32x4*)(Am + (16 * bq + r16) * ASTR + 16 * j + 4 * q4);
#pragma unroll
                for (int ct = 0; ct < 2; ++ct) {
                    acc[ct] = __builtin_amdgcn_mfma_f32_16x16x4f32(a4.x, X[ct][j][0], acc[ct], 0, 0, 0); acc[ct] = __builtin_amdgcn_mfma_f32_16x16x4f32(a4.y, X[ct][j][1], acc[ct], 0, 0, 0);
                    acc[ct] = __builtin_amdgcn_mfma_f32_16x16x4f32(a4.z, X[ct][j][2], acc[ct], 0, 0, 0); acc[ct] = __builtin_amdgcn_mfma_f32_16x16x4f32(a4.w, X[ct][j][3], acc[ct], 0, 0, 0); } }
            const f32x4 t4 = *(const LAS f32x4*)(Td + (bq * 16 + r16) * TDSTR + 4 * q4);
#pragma unroll
            for (int ct = 0; ct < 2; ++ct) {
                f32x4 y;
#pragma unroll
                for (int r = 0; r < 4; ++r) { const int i = 16 * bq + 4 * q4 + r; float rv = bf2f(src[i * VBSTR + ccol[ct]]) * bs[i]; if (!isu) rv *= __expf(Gs[i]); y[r] = rv - acc[ct][r]; }
                f32x4 xx = (f32x4){0.f, 0.f, 0.f, 0.f};
                xx = __builtin_amdgcn_mfma_f32_16x16x4f32(t4.x, y[0], xx, 0, 0, 0); xx = __builtin_amdgcn_mfma_f32_16x16x4f32(t4.y, y[1], xx, 0, 0, 0);
                xx = __builtin_amdgcn_mfma_f32_16x16x4f32(t4.z, y[2], xx, 0, 0, 0); xx = __builtin_amdgcn_mfma_f32_16x16x4f32(t4.w, y[3], xx, 0, 0, 0);
                X[ct][bq] = xx;
#pragma unroll
                for (int r = 0; r < 4; ++r) dbase[(16 * bq + 4 * q4 + r) * 128 + dcol[ct]] = (bf16)f2bf(xx[r]);
            }
        }
    }
    }
    LDS_BARRIER();
}

constexpr int DNB_W = 0, DNB_QG = 16384, DNB_KGT = 32768, DNB_ATT = 49152, DNB_BYTES = 57344, DNB_U = 2 * DNB_BYTES, DNB_O = DNB_U + 16384, OSTR = 136, DNB_NW = DNB_O + 64 * OSTR * 2, DNB_END = DNB_NW + 512;
static_assert(DNB_END <= LDSCTL_OFF, "DNSCAN LDS map");
__device__ __forceinline__ void dnscan_wg(const Args& a, int l, int bh, int c0, int c1, LAS unsigned char* lds, int tid) {
    const int lane = tid & 63, wave = __builtin_amdgcn_readfirstlane(tid >> 6), q4 = lane >> 4, r16 = lane & 15;
    const int b = bh >> 2, h = bh & 3;
    const bf16* PROJ = (const bf16*)(a.ws + WS_H); bf16* MIX = (bf16*)(a.ws + WS_MIX);
    if (wave < 4) {
        f32x4 S[2][8];
        f32x4* sst = (f32x4*)(a.ws + WS_SST) + (size_t)bh * 16 * 256 + tid;
#pragma unroll
        for (int ct = 0; ct < 2; ++ct)
#pragma unroll
            for (int j = 0; j < 8; ++j) S[ct][j] = c0 > 0 ? sst[256 * (8 * ct + j)] : (f32x4){0.f, 0.f, 0.f, 0.f};
        int fA[4], fB[2];
#pragma unroll
        for (int kk = 0; kk < 4; ++kk) fA[kk] = r16 * 256 + (((4 * kk + q4) ^ r16) << 4);
#pragma unroll
        for (int k2 = 0; k2 < 2; ++k2) fB[k2] = r16 * 128 + (((4 * k2 + q4) ^ ((r16 >> 1) & 7)) << 4);
        int uoff[2][4];
#pragma unroll
        for (int ct = 0; ct < 2; ++ct)
#pragma unroll
            for (int r = 0; r < 4; ++r) uoff[ct][r] = (4 * q4) * 256 + ((((4 * wave + 2 * ct + (r16 >> 3)) ^ ((4 * q4 + r) & 15))) << 4) + 2 * (r16 & 7);
        LAS bf16* obase = (LAS bf16*)(lds + DNB_O) + (4 * q4) * OSTR + 32 * wave + r16;
        LDS_BARRIER();
        unsigned long long dnt_acc = 0, dnt_t0 = 0; (void)dnt_t0;
#pragma unroll 1
        for (int c = c0; c < c1; ++c) {
            const LAS unsigned char* bb = lds + (c & 1) * DNB_BYTES;
            if (PROBE_DNT == 3) dnt_t0 = __builtin_amdgcn_s_memtime();
            const float egl = ((const float*)(a.ws + DI_EGL))[bh * 32 + c];
            bf16x8v sb[2][4];
#pragma unroll
            for (int ct = 0; ct < 2; ++ct)
#pragma unroll
                for (int kk = 0; kk < 4; ++kk) sb[ct][kk] = pack8(S[ct][2 * kk], S[ct][2 * kk + 1]);
#define DN_SB() __builtin_amdgcn_sched_barrier(0)
            f32x4 vn[2][4];
#pragma unroll
            for (int hf = 0; hf < 2; ++hf) {
                bf16x8v fw[2][4]; float uv[2][8];
#pragma unroll
                for (int i = 0; i < 2; ++i) {
#pragma unroll
                    for (int kk = 0; kk < 4; ++kk) fw[i][kk] = *(const LAS bf16x8v*)(bb + DNB_W + (2 * hf + i) * 4096 + fA[kk]);
#pragma unroll
                    for (int ct = 0; ct < 2; ++ct)
#pragma unroll
                        for (int r = 0; r < 4; ++r) uv[ct][4 * i + r] = bf2f(*(const LAS bf16*)(lds + DNB_U + (2 * hf + i) * 4096 + r * 256 + uoff[ct][r])); }
#pragma unroll
                for (int ct = 0; ct < 2; ++ct) { vn[ct][2 * hf] = (f32x4){0.f, 0.f, 0.f, 0.f}; vn[ct][2 * hf + 1] = (f32x4){0.f, 0.f, 0.f, 0.f}; }
                DN_SB();
#pragma unroll
                for (int kk = 0; kk < 4; ++kk)
#pragma unroll
                    for (int i = 0; i < 2; ++i)
#pragma unroll
                        for (int ct = 0; ct < 2; ++ct) vn[ct][2 * hf + i] = __builtin_amdgcn_mfma_f32_16x16x32_bf16(fw[i][kk], sb[ct][kk], vn[ct][2 * hf + i], 0, 0, 0);
#pragma unroll
                for (int ct = 0; ct < 2; ++ct)
#pragma unroll
                    for (int i = 0; i < 2; ++i)
#pragma unroll
                        for (int r = 0; r < 4; ++r) vn[ct][2 * hf + i][r] = uv[ct][4 * i + r] - vn[ct][2 * hf + i][r];
            }
            bf16x8v vb[2][2];
#pragma unroll
            for (int ct = 0; ct < 2; ++ct) { vb[ct][0] = pack8(vn[ct][0], vn[ct][1]); vb[ct][1] = pack8(vn[ct][2], vn[ct][3]); }
            if (PROBE_DNT == 3) { asm volatile("s_waitcnt lgkmcnt(0)" ::: "memory"); dnt_acc += __builtin_amdgcn_s_memtime() - dnt_t0; }
            if (PROBE_DNT == 1) { asm volatile("s_waitcnt lgkmcnt(0)" ::: "memory"); dnt_t0 = __builtin_amdgcn_s_memtime(); __builtin_amdgcn_s_barrier(); dnt_acc += __builtin_amdgcn_s_memtime() - dnt_t0; asm volatile("" ::: "memory"); } else
            LDS_BARRIER();
#pragma unroll
            for (int hf = 0; hf < 2; ++hf) {
                f32x4 o[2][2];
                bf16x8v fq[2][4], fa[2][2];
#pragma unroll
                for (int i = 0; i < 2; ++i) {
#pragma unroll
                    for (int kk = 0; kk < 4; ++kk) fq[i][kk] = *(const LAS bf16x8v*)(bb + DNB_QG + (2 * hf + i) * 4096 + fA[kk]);
#pragma unroll
                    for (int k2 = 0; k2 < 2; ++k2) fa[i][k2] = *(const LAS bf16x8v*)(bb + DNB_ATT + (2 * hf + i) * 2048 + fB[k2]); }
#pragma unroll
                for (int ct = 0; ct < 2; ++ct) { o[ct][0] = (f32x4){0.f, 0.f, 0.f, 0.f}; o[ct][1] = (f32x4){0.f, 0.f, 0.f, 0.f}; }
                DN_SB();
#pragma unroll
                for (int kk = 0; kk < 4; ++kk)
#pragma unroll
                    for (int i = 0; i < 2; ++i)
#pragma unroll
                        for (int ct = 0; ct < 2; ++ct) o[ct][i] = __builtin_amdgcn_mfma_f32_16x16x32_bf16(fq[i][kk], sb[ct][kk], o[ct][i], 0, 0, 0);
#pragma unroll
                for (int k2 = 0; k2 < 2; ++k2)
#pragma unroll
                    for (int i = 0; i < 2; ++i)
#pragma unroll
                        for (int ct = 0; ct < 2; ++ct) o[ct][i] = __builtin_amdgcn_mfma_f32_16x16x32_bf16(fa[i][k2], vb[ct][k2], o[ct][i], 0, 0, 0);
#pragma unroll
                for (int ct = 0; ct < 2; ++ct)
#pragma unroll
                    for (int i = 0; i < 2; ++i)
#pragma unroll
                        for (int r = 0; r < 4; ++r) obase[(16 * (2 * hf + i) + r) * OSTR + 16 * ct] = (bf16)f2bf(o[ct][i][r]);
            }
#pragma unroll
            for (int ct = 0; ct < 2; ++ct)
#pragma unroll
                for (int j = 0; j < 8; ++j) S[ct][j] = S[ct][j] * egl;
#pragma unroll
            for (int hf = 0; hf < 2; ++hf) {
                bf16x8v fk[4][2];
#pragma unroll
                for (int j = 0; j < 4; ++j)
#pragma unroll
                    for (int k2 = 0; k2 < 2; ++k2) fk[j][k2] = *(const LAS bf16x8v*)(bb + DNB_KGT + (4 * hf + j) * 2048 + fB[k2]);
                DN_SB();
#pragma unroll
                for (int k2 = 0; k2 < 2; ++k2)
#pragma unroll
                    for (int j = 0; j < 4; ++j)
#pragma unroll
                        for (int ct = 0; ct < 2; ++ct) S[ct][4 * hf + j] = __builtin_amdgcn_mfma_f32_16x16x32_bf16(fk[j][k2], vb[ct][k2], S[ct][4 * hf + j], 0, 0, 0);
            }
#undef DN_SB
            if (PROBE_DNT == 2) { asm volatile("s_waitcnt lgkmcnt(0)" ::: "memory"); dnt_t0 = __builtin_amdgcn_s_memtime(); __builtin_amdgcn_s_barrier(); dnt_acc += __builtin_amdgcn_s_memtime() - dnt_t0; asm volatile("" ::: "memory"); } else
            LDS_BARRIER();
        }
        if (PROBE_DNT >= 1 && PROBE_DNT <= 3 && wave == 0) { const unsigned long long te = __builtin_amdgcn_s_memtime(); while (__builtin_amdgcn_s_memtime() - te < DNT_K * dnt_acc) __builtin_amdgcn_s_sleep(4); }
        if (c1 < 32) {
#pragma unroll
            for (int ct = 0; ct < 2; ++ct)
#pragma unroll
                for (int j = 0; j < 8; ++j) sst[256 * (8 * ct + j)] = S[ct][j];
        } else {
            float* So = a.out + OFF_DP + (((size_t)(l * NB + b) * DNH + h) << 14) + 32 * wave + r16;
#pragma unroll
            for (int ct = 0; ct < 2; ++ct)
#pragma unroll
                for (int j = 0; j < 8; ++j)
#pragma unroll
                    for (int r = 0; r < 4; ++r) So[(16 * j + 4 * q4 + r) * 128 + 16 * ct] = S[ct][j][r];
        }
        LDS_BARRIER();
    } else {
        const int et = tid - 256;
        int offA[4], offB[4];
#pragma unroll
        for (int n = 0; n < 4; ++n) { const int p = et + 256 * n; offA[n] = (p >> 4) * 256 + (((p & 15) ^ ((p >> 4) & 15)) << 4); offB[n] = (p >> 3) * 128 + (((p & 7) ^ ((p >> 4) & 7)) << 4); }
        v4u pw[4], pq[4], pk[4], pa[2], pu[4];
#define DN_ISSUE(cn) do { const size_t it_ = (size_t)(bh * 32 + (cn)); \
        const v4u* gw = (const v4u*)((const bf16*)(a.ws + DI_W) + it_ * 8192) + et; const v4u* gq = (const v4u*)((const bf16*)(a.ws + DI_QG) + it_ * 8192) + et; \
        const v4u* gk = (const v4u*)((const bf16*)(a.ws + DI_KGT) + it_ * 8192) + et; const v4u* ga = (const v4u*)((const bf16*)(a.ws + DI_ATT) + it_ * 4096) + et; \
        const v4u* gu = (const v4u*)((const bf16*)(a.ws + DI_U) + it_ * 8192) + et; \
        _Pragma("unroll") for (int n_ = 0; n_ < 4; ++n_) { pw[n_] = gw[256 * n_]; pq[n_] = gq[256 * n_]; pk[n_] = gk[256 * n_]; pu[n_] = gu[256 * n_]; } \
        pa[0] = ga[0]; pa[1] = ga[256]; } while (0)
#define DN_COMMIT_OPS(cn) do { LAS unsigned char* bb_ = lds + ((cn) & 1) * DNB_BYTES; \
        _Pragma("unroll") for (int n_ = 0; n_ < 4; ++n_) { *(LAS v4u*)(bb_ + DNB_W + offA[n_]) = pw[n_]; *(LAS v4u*)(bb_ + DNB_QG + offA[n_]) = pq[n_]; *(LAS v4u*)(bb_ + DNB_KGT + offB[n_]) = pk[n_]; } \
        *(LAS v4u*)(bb_ + DNB_ATT + offB[0]) = pa[0]; *(LAS v4u*)(bb_ + DNB_ATT + offB[1]) = pa[1]; } while (0)
#define DN_COMMIT_U() do { _Pragma("unroll") for (int n_ = 0; n_ < 4; ++n_) *(LAS v4u*)(lds + DNB_U + offA[n_]) = pu[n_]; } while (0)
        const int ew = wave - 4, trow = 16 * ew + (lane >> 2), cg = lane & 3;
        v4u zc[4];
        if (et < 32) { int e2 = et; asm volatile("" : "+v"(e2)); *(LAS f32x4*)(lds + DNB_NW + 16 * e2) = ((const f32x4*)(a.in[I_DNNW] + l * DHD))[e2]; }
#define DN_ZLOAD(cz) do { const v4u* zp = (const v4u*)(PROJ + (size_t)(b * SEQ + 64 * (cz) + trow) * NPROJ + 2560 + h * 128 + 32 * cg); \
        _Pragma("unroll") for (int k_ = 0; k_ < 4; ++k_) zc[k_] = zp[k_]; } while (0)
        DN_ISSUE(c0);
        DN_COMMIT_OPS(c0); DN_COMMIT_U();
        if (c0 + 1 < c1) DN_ISSUE(c0 + 1);
        DN_ZLOAD(c0);
        LDS_BARRIER();
#define DN_EPI_READ() v4u ov[4]; { const LAS v4u* op = (const LAS v4u*)((LAS bf16*)(lds + DNB_O) + trow * OSTR + 32 * cg); _Pragma("unroll") for (int k_ = 0; k_ < 4; ++k_) ov[k_] = op[k_]; }
#define DN_EPI_FINISH(cp) do { float ss_ = 0.f; \
        _Pragma("unroll") for (int k_ = 0; k_ < 4; ++k_) { const unsigned w4_[4] = {ov[k_].x, ov[k_].y, ov[k_].z, ov[k_].w}; \
            _Pragma("unroll") for (int e_ = 0; e_ < 4; ++e_) { const float o0_ = __builtin_bit_cast(float, w4_[e_] << 16), o1_ = __builtin_bit_cast(float, w4_[e_] & 0xffff0000u); ss_ += o0_ * o0_ + o1_ * o1_; } } \
        ss_ = DPP_ADD(ss_, 0xB1); ss_ = DPP_ADD(ss_, 0x4E); \
        const float rstd_ = __builtin_amdgcn_rsqf(ss_ * (1.0f / DHD) + EPS); \
        v4u* mp_ = (v4u*)(MIX + (size_t)(b * SEQ + 64 * (cp) + trow) * DM + 512 + h * 128 + 32 * cg); \
        const LAS f32x4* nwp_ = (const LAS f32x4*)(lds + DNB_NW) + 8 * cg; \
        _Pragma("unroll") for (int k_ = 0; k_ < 4; ++k_) { const unsigned w4_[4] = {ov[k_].x, ov[k_].y, ov[k_].z, ov[k_].w}; const unsigned z4_[4] = {zc[k_].x, zc[k_].y, zc[k_].z, zc[k_].w}; unsigned r4_[4]; \
            const f32x4 nwa_ = nwp_[2 * k_], nwb_ = nwp_[2 * k_ + 1]; const float nw8_[8] = {nwa_.x, nwa_.y, nwa_.z, nwa_.w, nwb_.x, nwb_.y, nwb_.z, nwb_.w}; \
            _Pragma("unroll") for (int e_ = 0; e_ < 4; ++e_) { const float z0_ = __builtin_bit_cast(float, z4_[e_] << 16), z1_ = __builtin_bit_cast(float, z4_[e_] & 0xffff0000u); \
                const float o0_ = __builtin_bit_cast(float, w4_[e_] << 16), o1_ = __builtin_bit_cast(float, w4_[e_] & 0xffff0000u); \
                r4_[e_] = cvtpk_s(o0_ * rstd_ * nw8_[2 * e_] * silu_fast(z0_), o1_ * rstd_ * nw8_[2 * e_ + 1] * silu_fast(z1_)); } \
            mp_[k_] = (v4u){r4_[0], r4_[1], r4_[2], r4_[3]}; } } while (0)
        unsigned long long dnt_acc = 0, dnt_t0 = 0; (void)dnt_t0;
#pragma unroll 1
        for (int c = c0; c < c1; ++c) {
            if (PROBE_DNT == 6) dnt_t0 = __builtin_amdgcn_s_memtime();
            if (c > c0) { DN_EPI_READ();
                if (c + 1 < c1) DN_COMMIT_OPS(c + 1);
                if (PROBE_DNT == 6) { asm volatile("s_waitcnt lgkmcnt(0)" ::: "memory"); dnt_acc += __builtin_amdgcn_s_memtime() - dnt_t0; }
                if (PROBE_DNT == 4) { asm volatile("s_waitcnt lgkmcnt(0)" ::: "memory"); dnt_t0 = __builtin_amdgcn_s_memtime(); __builtin_amdgcn_s_barrier(); dnt_acc += __builtin_amdgcn_s_memtime() - dnt_t0; asm volatile("" ::: "memory"); } else
                LDS_BARRIER();
                if (c + 1 < c1) DN_COMMIT_U();
                DN_EPI_FINISH(c - 1);
                asm volatile("" ::: "memory");
                DN_ZLOAD(c);
                if (c + 2 < c1) DN_ISSUE(c + 2);
            } else {
                if (c + 1 < c1) DN_COMMIT_OPS(c + 1);
                LDS_BARRIER();
                if (c + 1 < c1) DN_COMMIT_U();
                if (c + 2 < c1) DN_ISSUE(c + 2);
            }
            if (PROBE_DNT == 5) { asm volatile("s_waitcnt lgkmcnt(0)" ::: "memory"); dnt_t0 = __builtin_amdgcn_s_memtime(); __builtin_amdgcn_s_barrier(); dnt_acc += __builtin_amdgcn_s_memtime() - dnt_t0; asm volatile("" ::: "memory"); } else
            LDS_BARRIER();
        }
        { DN_EPI_READ(); DN_EPI_FINISH(c1 - 1); }
        if (PROBE_DNT >= 4 && wave == 4) { const unsigned long long te = __builtin_amdgcn_s_memtime(); while (__builtin_amdgcn_s_memtime() - te < DNT_K * dnt_acc) __builtin_amdgcn_s_sleep(4); }
        LDS_BARRIER();
#undef DN_ISSUE
#undef DN_COMMIT_OPS
#undef DN_COMMIT_U
#undef DN_ZLOAD
#undef DN_EPI_READ
#undef DN_EPI_FINISH
    }
}


constexpr size_t RG_SUMS = WS_XN + 9 * MiB;
constexpr size_t RG_AV = 353 * MiB, RG_BV = RG_AV + 32 * MiB;
constexpr int XSTR = 68;
constexpr int XBSTR = 72;
constexpr int PSTR = 64;
constexpr int RG_RAW = 0, RG_XS = 68608, RG_PA = RG_XS + 64 * XSTR * 4, RG_PX = RG_PA + 64 * PSTR * 4, RG_XB = RG_PX + 64 * PSTR * 4, RG_PP = RG_XB + 64 * XBSTR * 2, RG_HH = RG_PP + 2048, RG_HIN = RG_HH + 2048, RG_END = RG_HIN + 2048;
static_assert(RG_END <= LDSCTL_OFF, "RG tile LDS map");
template <bool FIN>
__device__ __forceinline__ void rg_tile(const Args& a, int l, int tile, LAS unsigned char* lds, int tid) {
    asm volatile("" : "+v"(tid));
    LAS bf16* raw = (LAS bf16*)(lds + RG_RAW);
    LAS float* xs = (LAS float*)(lds + RG_XS);
    LAS float* pa = (LAS float*)(lds + RG_PA);
    LAS float* px = (LAS float*)(lds + RG_PX);
    LAS bf16* xb = (LAS bf16*)(lds + RG_XB);
    LAS float* PP = (LAS float*)(lds + RG_PP);
    LAS float* HH = (LAS float*)(lds + RG_HH);
    LAS float* hin = (LAS float*)(lds + RG_HIN);
    const int lane = tid & 63, wave = __builtin_amdgcn_readfirstlane(tid >> 6), q4 = lane >> 4, r16 = lane & 15;
    const bool prompt = tile < NB * 32;
    const int b = tile >> 5, c = tile & 31, gsm = tile - NB * 32;
    const int mbase = prompt ? b * SEQ + 64 * c : MP + 64 * gsm;
    const bf16* PROJ = (const bf16*)(a.ws + WS_H);
    float* SUMS = (float*)(a.ws + RG_SUMS);
    const bool light = FIN && prompt;
    if (!light)
#pragma unroll
    for (int n = 0; n < 9; ++n) { const int p = tid + 512 * n; if (p < 67 * 64) { const int slot = p >> 6, pc = p & 63, m = mbase - 3 + slot;
        v4u v = (v4u){0u, 0u, 0u, 0u};
        if (slot >= 3 || (prompt && c > 0)) v = *(const v4u*)(PROJ + (size_t)m * NPROJ + 8 * pc);
        *(LAS v4u*)(raw + slot * 512 + 8 * pc) = v; } }
    if (FIN && prompt) {
        float Pv[31], Hv[31];
#pragma unroll
        for (int cc = 0; cc < 31; ++cc) { Pv[cc] = 1.f; Hv[cc] = 0.f; if (cc < c) { const float* sp = SUMS + (size_t)(b * 32 + cc) * 1024; Pv[cc] = sp[tid]; Hv[cc] = sp[512 + tid]; } }
        float hh = 0.f;
#pragma unroll
        for (int cc = 0; cc < 31; ++cc) hh = Pv[cc] * hh + Hv[cc];
        hin[tid] = hh;
    }
    float nbwf[16], nba = 0.f, nbx = 0.f, nlam = 0.f; f32x4 ncw[8], ncb[2];
#define RG_LOAD_HEAD(hh_) do { const int ch_ = (hh_) * 64 + lane; \
        const float* wm_ = a.in[(wave >> 2) ? I_RGWX : I_RGWA] + ((size_t)(l * 8 + (hh_)) * 64) * 64 + 16 * (wave & 3) + r16; \
        _Pragma("unroll") for (int kk_ = 0; kk_ < 2; ++kk_) _Pragma("unroll") for (int jj_ = 0; jj_ < 8; ++jj_) nbwf[8 * kk_ + jj_] = wm_[(32 * kk_ + 8 * q4 + jj_) * 64]; \
        nba = a.in[I_RGBA][l * RGW + ch_]; nbx = a.in[I_RGBX][l * RGW + ch_]; nlam = a.in[I_LAM][l * RGW + ch_]; \
        const int chb_ = (hh_) * 64 + 8 * (tid & 7); \
        _Pragma("unroll") for (int tap_ = 0; tap_ < 4; ++tap_) { const f32x4* wp_ = (const f32x4*)(a.in[I_CONVW] + ((size_t)l * 4 + tap_) * CONVCH + chb_); ncw[2 * tap_] = wp_[0]; ncw[2 * tap_ + 1] = wp_[1]; } \
        { const f32x4* bp_ = (const f32x4*)(a.in[I_CONVB] + l * RGW + chb_); ncb[0] = bp_[0]; ncb[1] = bp_[1]; } } while (0)
    if (!light) RG_LOAD_HEAD(0);
    LDS_BARRIER();
#pragma unroll 1
    for (int hd = 0; hd < 8; ++hd) {
        const int ch = hd * 64 + lane;
        float av[8], bv[8], P = 1.f, Hl = 0.f;
        float gv[8];
        if (FIN) {
#pragma unroll
            for (int t = 0; t < 8; ++t) gv[t] = bf2f(PROJ[(size_t)(mbase + 8 * wave + t) * NPROJ + 2048 + ch]);
        }
        if (light) {
            const float* ap = (const float*)(a.ws + RG_AV) + (size_t)(mbase + 8 * wave) * RGW + ch; const float* bp = (const float*)(a.ws + RG_BV) + (size_t)(mbase + 8 * wave) * RGW + ch;
#pragma unroll
            for (int t = 0; t < 8; ++t) { av[t] = ap[t * RGW]; bv[t] = bp[t * RGW]; }
#pragma unroll
            for (int t = 0; t < 8; ++t) { P *= av[t]; Hl = av[t] * Hl + bv[t]; }
        } else {
        float bwf[16];
#pragma unroll
        for (int x = 0; x < 16; ++x) bwf[x] = nbwf[x];
        const float ba = nba, bx = nbx, lam = nlam;
        f32x4 cwv[8], cbv[2];
#pragma unroll
        for (int x = 0; x < 8; ++x) cwv[x] = ncw[x];
        cbv[0] = ncb[0]; cbv[1] = ncb[1];
        if (hd + 1 < 8) RG_LOAD_HEAD(hd + 1);
        {
            const int i = tid >> 3, sub = tid & 7, chb = hd * 64 + 8 * sub;
            const int t = prompt ? 3 : (i & 7);
            float o[8];
            { const f32x4 b0 = cbv[0], b1 = cbv[1]; o[0] = b0.x; o[1] = b0.y; o[2] = b0.z; o[3] = b0.w; o[4] = b1.x; o[5] = b1.y; o[6] = b1.z; o[7] = b1.w; }
#pragma unroll
            for (int tap = 0; tap < 4; ++tap) {
                const int back = 3 - tap;
                const f32x4 w0 = cwv[2 * tap], w1 = cwv[2 * tap + 1];
                float xv[8];
                if (t - back >= 0) { const v4u x0 = *(const LAS v4u*)(raw + (3 + i - back) * 512 + chb);
                    xv[0] = __builtin_bit_cast(float, x0.x << 16); xv[1] = __builtin_bit_cast(float, x0.x & 0xffff0000u); xv[2] = __builtin_bit_cast(float, x0.y << 16); xv[3] = __builtin_bit_cast(float, x0.y & 0xffff0000u);
                    xv[4] = __builtin_bit_cast(float, x0.z << 16); xv[5] = __builtin_bit_cast(float, x0.z & 0xffff0000u); xv[6] = __builtin_bit_cast(float, x0.w << 16); xv[7] = __builtin_bit_cast(float, x0.w & 0xffff0000u); }
                else { const f32x4* sp = (const f32x4*)(a.in[I_SCONV] + ((size_t)(l * NDB + 8 * gsm + (i >> 3)) * 3 + (3 + t - back)) * CONVCH + chb);
                    const f32x4 s0 = sp[0], s1 = sp[1]; xv[0] = s0.x; xv[1] = s0.y; xv[2] = s0.z; xv[3] = s0.w; xv[4] = s1.x; xv[5] = s1.y; xv[6] = s1.z; xv[7] = s1.w; }
                o[0] += w0.x * xv[0]; o[1] += w0.y * xv[1]; o[2] += w0.z * xv[2]; o[3] += w0.w * xv[3];
                o[4] += w1.x * xv[4]; o[5] += w1.y * xv[5]; o[6] += w1.z * xv[6]; o[7] += w1.w * xv[7];
            }
            LAS float* dst = xs + i * XSTR + 8 * sub;
            *(LAS f32x4*)dst = (f32x4){o[0], o[1], o[2], o[3]}; *(LAS f32x4*)(dst + 4) = (f32x4){o[4], o[5], o[6], o[7]};
            v4u ob; ob.x = cvtpk_s(o[0], o[1]); ob.y = cvtpk_s(o[2], o[3]); ob.z = cvtpk_s(o[4], o[5]); ob.w = cvtpk_s(o[6], o[7]);
            *(LAS v4u*)(xb + i * XBSTR + 8 * sub) = ob;
        }
        LDS_BARRIER();
        {
            bf16x8v bw[2];
            bw[0] = pack8((f32x4){bwf[0], bwf[1], bwf[2], bwf[3]}, (f32x4){bwf[4], bwf[5], bwf[6], bwf[7]});
            bw[1] = pack8((f32x4){bwf[8], bwf[9], bwf[10], bwf[11]}, (f32x4){bwf[12], bwf[13], bwf[14], bwf[15]});
            LAS float* outp = ((wave >> 2) ? px : pa) + 16 * (wave & 3) + r16;
            bf16x8v af[4][2];
#pragma unroll
            for (int ti = 0; ti < 4; ++ti)
#pragma unroll
                for (int kk = 0; kk < 2; ++kk) af[ti][kk] = *(const LAS bf16x8v*)(xb + (16 * ti + r16) * XBSTR + 32 * kk + 8 * q4);
#pragma unroll
            for (int ti = 0; ti < 4; ++ti) {
                f32x4 acc = (f32x4){0.f, 0.f, 0.f, 0.f};
                acc = __builtin_amdgcn_mfma_f32_16x16x32_bf16(af[ti][0], bw[0], acc, 0, 0, 0);
                acc = __builtin_amdgcn_mfma_f32_16x16x32_bf16(af[ti][1], bw[1], acc, 0, 0, 0);
#pragma unroll
                for (int r = 0; r < 4; ++r) outp[(16 * ti + 4 * q4 + r) * PSTR] = acc[r];
            }
        }
        LDS_BARRIER();
        const float spl = softplus_f(-lam);
#pragma unroll
        for (int t = 0; t < 8; ++t) { const int i = 8 * wave + t;
            const float r = sigmoid_f(pa[i * PSTR + lane] + ba), ig = sigmoid_f(px[i * PSTR + lane] + bx), la = -8.0f * r * spl;
            av[t] = __builtin_amdgcn_exp2f(1.44269504089f * la); bv[t] = __builtin_amdgcn_sqrtf(neg_expm1_f(2.0f * la)) * (ig * xs[i * XSTR + lane]);
            P *= av[t]; Hl = av[t] * Hl + bv[t]; }
        if (!FIN) {
            float* ap = (float*)(a.ws + RG_AV) + (size_t)(mbase + 8 * wave) * RGW + ch; float* bp = (float*)(a.ws + RG_BV) + (size_t)(mbase + 8 * wave) * RGW + ch;
#pragma unroll
            for (int t = 0; t < 8; ++t) { ap[t * RGW] = av[t]; bp[t * RGW] = bv[t]; }
        }
        }
        float hh;
        if (prompt) {
            PP[wave * 64 + lane] = P; HH[wave * 64 + lane] = Hl;
            LDS_BARRIER();
            hh = FIN ? hin[ch] : 0.f;
            for (int g = 0; g < wave; ++g) hh = PP[g * 64 + lane] * hh + HH[g * 64 + lane];
            if (!FIN && wave == 7) {
                float pt = P;
#pragma unroll
                for (int g = 0; g < 7; ++g) pt *= PP[g * 64 + lane];
                float* sp = SUMS + (size_t)tile * 1024; sp[ch] = pt; sp[512 + ch] = P * hh + Hl;
            }
        } else hh = a.in[I_SRG][(size_t)(l * NDB + 8 * gsm + wave) * RGW + ch];
        if (FIN) {
            bf16* MIX = (bf16*)(a.ws + WS_MIX);
#pragma unroll
            for (int t = 0; t < 8; ++t) { const size_t m = (size_t)(mbase + 8 * wave + t);
                hh = av[t] * hh + bv[t];
                MIX[m * DM + ch] = (bf16)f2bf(hh * gelu_tanh_f(gv[t])); }
            if (prompt) { if (c == 31 && wave == 7) a.out[OFF_RP + (size_t)(l * NB + b) * RGW + ch] = hh; }
            else a.out[OFF_RS + (size_t)(l * NDB + 8 * gsm + wave) * RGW + ch] = hh;
        }
        LDS_BARRIER();
    }
#undef RG_LOAD_HEAD
}


constexpr int NSCAN = NB * DNH;
constexpr int CSPLIT = 16;
__device__ __forceinline__ void prepa_newconv(const Args& a, int l, int tid) {
    const bf16* PROJ = (const bf16*)(a.ws + WS_H);
    for (int idx = blockIdx.x * (NWAVES * 64) + tid; idx < (NB + NDB) * 3 * CONVCH; idx += gridDim.x * NWAVES * 64) {
        const int c = idx & (CONVCH - 1), jr = (idx >> 11) % 3, sq = idx / (3 * CONVCH);
        if (sq < NB) a.out[OFF_CP + ((size_t)(l * NB + sq) * 3 + jr) * CONVCH + c] = bf2f(PROJ[(size_t)(sq * SEQ + SEQ - 3 + jr) * NPROJ + c]);
        else { const int bs = sq - NB; a.out[OFF_CS + ((size_t)(l * NDB + bs) * 3 + jr) * CONVCH + c] = bf2f(PROJ[(size_t)(MP + bs * DSEQ + DSEQ - 3 + jr) * NPROJ + c]); }
    }
}
__device__ __forceinline__ void prepa_phase(const Args& a, int l, int qid, LAS unsigned char* lds, volatile LAS unsigned* MISC, int tid0) {
    gu32* ctr = (gu32*)(a.ws + WS_CTL) + CW_QUEUE + 64 * qid;
    for (;;) {
        int tid = tid0; asm volatile("" : "+v"(tid));
        const int j = queue_next(ctr, MISC + 16, tid);
        if (j >= NSCAN * CSPLIT) break;
        dnprep_item(a, l, (j / CSPLIT) * 32 + (j % CSPLIT), lds, tid);
    }
    int tid = tid0; asm volatile("" : "+v"(tid));
    prepa_newconv(a, l, tid);
}
__device__ __forceinline__ void mid_phase(const Args& a, int l, int qid, LAS unsigned char* lds, volatile LAS unsigned* MISC, int tid0) {
    if ((int)blockIdx.x < NSCAN || (int)gridDim.x <= NSCAN) {
        int tid = tid0; asm volatile("" : "+v"(tid));
        for (int rp = 0; rp < PROBE_SFA; ++rp) for (int it = blockIdx.x; it < NSCAN; it += gridDim.x) dnscan_wg(a, l, it, 0, CSPLIT, lds, tid);
    }
    gu32* ctr = (gu32*)(a.ws + WS_CTL) + CW_QUEUE + 64 * qid;
    constexpr int NRG = NB * 32, NDN = NSCAN * (32 - CSPLIT);
    for (;;) {
        int tid = tid0; asm volatile("" : "+v"(tid));
        const int it = queue_next(ctr, MISC + 16, tid);
        if (it >= NRG + NDN) break;
        if (it < NRG) rg_tile<false>(a, l, it, lds, tid);
        else { const int j = it - NRG; dnprep_item(a, l, (j / (32 - CSPLIT)) * 32 + CSPLIT + (j % (32 - CSPLIT)), lds, tid); }
    }
}
__device__ __forceinline__ void fin_phase(const Args& a, int l, int qid, LAS unsigned char* lds, volatile LAS unsigned* MISC, int tid0) {
    if ((int)blockIdx.x < NSCAN || (int)gridDim.x <= NSCAN) {
        int tid = tid0; asm volatile("" : "+v"(tid));
        for (int rp = 0; rp < PROBE_SFA; ++rp) for (int it = blockIdx.x; it < NSCAN; it += gridDim.x) dnscan_wg(a, l, it, CSPLIT, 32, lds, tid);
    }
    gu32* ctr = (gu32*)(a.ws + WS_CTL) + CW_QUEUE + 64 * qid;
    constexpr int NRG = NB * 32 + NDB / 8, NDL = 2 * NDB;
    for (;;) {
        int tid = tid0; asm volatile("" : "+v"(tid));
        const int it = queue_next(ctr, MISC + 16, tid);
        const int NCV = l == 0 ? (WI_3 - WI_2 + NWAVES - 1) / NWAVES : 0;
        if (it >= NRG + NDL + NCV) break;
        if (it < NRG) rg_tile<true>(a, l, it, lds, tid);
        else if (it < NRG + NDL) delta_seq(a, l, it - NRG, lds, tid);
        else { const int w0 = WI_2 + (it - NRG - NDL) * NWAVES, wv = __builtin_amdgcn_readfirstlane(tid >> 6);
            wcvt_range(a, 0, w0 + wv, (w0 + NWAVES < WI_3 ? w0 + NWAVES : WI_3), 0, NWAVES, lds, wv, tid & 63);
            __syncthreads(); }
    }
}

constexpr int PH_PER_LAYER = 13, N_PHASES = DEPTH * PH_PER_LAYER;
enum { Q_WCVT = 0, Q_UP1, Q_DN1, Q_NORM1, Q_WIN, Q_PREPA, Q_MID, Q_FIN, Q_WOUT, Q_NORM2, Q_UP2, Q_DN2, Q_NORM3 };
__global__ void __launch_bounds__(NWAVES * 64, 2) fwd_kernel(Args a0) {
    extern __shared__ __attribute__((aligned(16))) unsigned char lds_raw[];
    LAS unsigned char* lds = (LAS unsigned char*)lds_raw;
    volatile LAS unsigned* MISC = (volatile LAS unsigned*)(lds + MISC_OFF);
    const int tid0 = threadIdx.x;
    for (int u = tid0; u < (LDS_BYTES - LDSCTL_OFF) / 4; u += NWAVES * 64) ((LAS unsigned*)(lds + LDSCTL_OFF))[u] = 0u;
    __syncthreads();
    const int lo = a0.ph_lo, hi = a0.ph_hi;
    gu32* ctl = (gu32*)(a0.ws + WS_CTL);
    typedef const __attribute__((address_space(4))) Args* CArgsP;
    CArgsP ap = (CArgsP)__builtin_amdgcn_kernarg_segment_ptr();
    XcdBarrier bar; bar.bar = (unsigned*)(ctl + CW_BAR); bar.x = 0; bar.st = nullptr;
    if (hi - lo > 1) bar = xcd_barrier_post((unsigned*)(ctl + CW_BAR), MISC + 8);
    const int hie = hi + (PROBE_Q >= 0 ? PROBE_REPS - 1 : 0);
    for (int st = lo; st < hie; ++st) {
        const int pi = (PROBE_Q >= 0 && st > PROBE_Q) ? (st - PROBE_Q < PROBE_REPS ? PROBE_Q : st - (PROBE_REPS - 1)) : st;
        asm volatile("" : "+s"(ap));
        const Args& a = *(const Args*)ap;
        int tid = tid0; asm volatile("" : "+v"(tid));
        const int lane = tid & 63, wave = __builtin_amdgcn_readfirstlane(tid >> 6);
        const int l = pi / PH_PER_LAYER, q = pi - l * PH_PER_LAYER;
        if (l == 1 && q == Q_WCVT && lo < pi) continue;

        if (q == Q_UP1 || q == Q_DN1 || q == Q_WIN || q == Q_WOUT || q == Q_UP2 || q == Q_DN2) {
#if EN_GEMM
            const bool isup = (q == Q_UP1 || q == Q_UP2), isdn = (q == Q_DN1 || q == Q_DN2);
            const bf16* A = (isup || q == Q_WIN) ? (const bf16*)(a.ws + WS_XN) : (isdn ? (const bf16*)(a.ws + WS_H) : (const bf16*)(a.ws + WS_MIX));
            const size_t wo = q == Q_UP1 ? WO_UP1 : q == Q_DN1 ? WO_DN1 : q == Q_WIN ? WO_WIN : q == Q_WOUT ? WO_WOUT : q == Q_UP2 ? WO_UP2 : WO_DN2;
            const int N = isup ? 2 * DFF : (q == Q_WIN ? NPROJ : DM), K = isdn ? DFF : DM;
            pg8::Gemm g{A, (const bf16*)(a.ws + WS_W + wo), M, N, K};
            const bool isd = !(isup || q == Q_WIN);
            const int nsp = isd ? (isdn ? NSPLIT_DN : NSPLIT_OUT) : 1;
            pg8::SplitOrder S; S.init(isd ? MP : M, isd ? MS : 0, N, K, nsp, gridDim.x, (int)blockIdx.x);
            pg8::EpiAny E{isup ? 0 : 1, isd ? (bf16*)(a.ws + WS_D) : (bf16*)(a.ws + WS_H), isup ? DFF : (isd ? DM : NPROJ), isd ? MP / 256 : M / 256, (bf16*)(a.ws + WS_DSLAB)};
            pg8::gemm_phase<pg8::EpiAny, pg8::SplitOrder, true, true>(lds, g, S, E);
#if EN_WCVT
            {
                const int nun = isd ? (MP / 256) * (N / 256) + (MS / 256) * (N / 256) * nsp : (M / 256) * (N / 256);
                const int nrem = nun % (int)gridDim.x, nidle = nrem ? (int)gridDim.x - nrem : (int)gridDim.x, me = nrem ? (int)blockIdx.x - nrem : (int)blockIdx.x;
                int lo_ = 0, hi_ = 0, lw = l;
                if (l == 0 && q == Q_WIN) { lo_ = WI_0; hi_ = WI_1; lw = 1; } else if (l == 0 && q == Q_UP2) { lo_ = WI_1; hi_ = WI_2; lw = 1; } else if (l == 1 && q == Q_WIN) { lo_ = WI_2; hi_ = WI_3; }
                if (hi_ > lo_ && me >= 0) wcvt_range(a, lw, lo_, hi_, me * NWAVES + wave, nidle * NWAVES, lds, wave, lane);
                __syncthreads();
            }
#endif
#endif
#if EN_SCAL
            if (q == Q_WIN) for (int rs = 0; rs < PROBE_SCAL; ++rs) scal_phase(a, l, lds, tid, wave, lane);
#endif
        } else if (q == Q_WCVT) {
#if EN_WCVT
            if (l == 0) { wcvt_range(a, 0, WI_0, WI_2, blockIdx.x * NWAVES + wave, gridDim.x * NWAVES, lds, wave, lane); xn0_phase(a, wave, lane); }
#endif
        } else if (q == Q_PREPA) {
#if EN_PREP
            prepa_phase(a, l, st, lds, MISC, tid);
#endif
        } else if (q == Q_MID) {
#if EN_PREP
            mid_phase(a, l, st, lds, MISC, tid);
#endif
        } else if (q == Q_FIN) {
#if EN_SCANFIN
            fin_phase(a, l, st, lds, MISC, tid);
#endif
        } else {
#if EN_NORM
            const int s = q == Q_NORM1 ? 0 : (q == Q_NORM2 ? 1 : 2);
            const float* gpost = a.in[s == 0 ? I_F1POST : (s == 1 ? I_MPOST : I_F2POST)] + l * DM;
            const float* gnext = s == 0 ? a.in[I_MPRE] + l * DM : (s == 1 ? a.in[I_F2PRE] + l * DM : (l + 1 < DEPTH ? a.in[I_F1PRE] + (l + 1) * DM : a.in[I_FINAL]));
            if (NORM_V2) norm_phase2(a, gpost, gnext, s == 1 ? 1.0f : 0.5f, 3 * l + s, pi == N_PHASES - 1, s == 1 ? NSPLIT_OUT : NSPLIT_DN, wave, lane);
            else norm_phase(a, gpost, gnext, s == 1 ? 1.0f : 0.5f, 3 * l + s, pi == N_PHASES - 1, s == 1 ? NSPLIT_OUT : NSPLIT_DN, wave, lane);
#endif
        }
        if (st + 1 < hie) for (int pb = 0; pb < PROBE_BAR; ++pb) xcd_barrier(bar);
    }
}

extern "C" void kernel_launch(void* const* d_in, const int* in_sizes, int n_in, void* d_out, int out_size, void* d_ws, size_t ws_size, hipStream_t stream) {
    static int grid = 0;
    if (grid == 0) {
        if (n_in != N_IN || out_size != (int)OUT_TOTAL || ws_size < WS_END) { fprintf(stderr, "kernel_launch: unexpected shapes (n_in %d, out %d, ws %zu); nothing launched\n", n_in, out_size, ws_size); grid = -1; return; }
        int dev = 0, cus = 0;
        if (hipGetDevice(&dev) != hipSuccess || hipDeviceGetAttribute(&cus, hipDeviceAttributeMultiprocessorCount, dev) != hipSuccess) { grid = -1; return; }
        if (hipFuncSetAttribute((const void*)fwd_kernel, hipFuncAttributeMaxDynamicSharedMemorySize, LDS_BYTES) != hipSuccess) { fprintf(stderr, "kernel_launch: hipFuncSetAttribute failed\n"); grid = -1; return; }
        (void)hipGetLastError();
        grid = cus;
    }
    if (grid < 0) return;
    if (hipMemsetAsync((char*)d_ws + WS_CTL, 0, CTL_ZERO_BYTES, stream) != hipSuccess) return;
    Args a{};
    for (int i = 0; i < N_IN; ++i) a.in[i] = (const float*)d_in[i];
    a.out = (float*)d_out; a.ws = (unsigned char*)d_ws;
#if MK_SINGLE
    a.ph_lo = 0; a.ph_hi = N_PHASES;
    hipLaunchKernelGGL(fwd_kernel, dim3(grid), dim3(NWAVES * 64), LDS_BYTES, stream, a);
#else
    for (int p = 0; p < N_PHASES; ++p) { a.ph_lo = p; a.ph_hi = p + 1; hipLaunchKernelGGL(fwd_kernel, dim3(grid), dim3(NWAVES * 64), LDS_BYTES, stream, a); }
#endif
}
```
